# Optimizing an MI355X kernel written in HIP

```python
import jax, jax.numpy as jnp
from jax import lax
import numpy as np

D_MODEL = 1024
BATCH = 4
SEQ = 8192
DEPTH = 4

CHUNK = 64
N_A_LAYERS = DEPTH // 2
N_B_LAYERS = DEPTH - N_A_LAYERS
EXPAND = 2
D_INNER = EXPAND * D_MODEL
POOL_WINDOWS = (2, 4, 8, 16)
N_POOL_GROUPS = len(POOL_WINDOWS)
POOL_GROUP_W = D_INNER // N_POOL_GROUPS
N_HEADS = 16
HEAD_DIM = D_INNER // N_HEADS
LEFT_CHUNKS = 8
BAND = (LEFT_CHUNKS + 1) * CHUNK
REL_CLIP = 128
EPS = 1e-6

kernel_name = "yoco_pool_chunkattn_adaln_trunk"


def rms_norm(x, g):
    xf = x.astype(jnp.float32)
    y = xf * lax.rsqrt(jnp.mean(xf * xf, axis=-1, keepdims=True) + EPS)
    return (y * g.astype(jnp.float32)).astype(x.dtype)


def modulate(h, shift, scale):
    return h * (1 + scale[:, None, :]) + shift[:, None, :]


def multiscale_pool(v):
    B, S, _ = v.shape
    vf = v.astype(jnp.float32).reshape(B, S, N_POOL_GROUPS, POOL_GROUP_W)
    cs = jnp.cumsum(vf, axis=1)
    t = jnp.arange(S)
    outs = []
    for g, w in enumerate(POOL_WINDOWS):
        csg = cs[:, :, g]
        lagged = jnp.pad(csg, ((0, 0), (w, 0), (0, 0)))[:, :S]
        cnt = jnp.minimum(t + 1, w).astype(jnp.float32)[None, :, None]
        outs.append((csg - lagged) / cnt - vf[:, :, g])
    return jnp.stack(outs, axis=2)


def chunk_band_attention(q, k, v, rel_bias):
    B, S, H, Dh = q.shape
    n_chunks = S // CHUNK
    pad = LEFT_CHUNKS * CHUNK
    k_pad = jnp.pad(k, ((0, 0), (pad, 0), (0, 0), (0, 0)))
    v_pad = jnp.pad(v, ((0, 0), (pad, 0), (0, 0), (0, 0)))
    qi = jnp.arange(CHUNK)[:, None]
    kj = jnp.arange(BAND)[None, :]
    dist = pad + qi - kj
    idx = jnp.clip(dist, -REL_CLIP, REL_CLIP) + REL_CLIP
    bias = rel_bias[:, idx].astype(jnp.float32)
    sm_scale = HEAD_DIM ** -0.5
    band_pos = jnp.arange(BAND) - pad

    def one_chunk(n):
        start = n * CHUNK
        qb = lax.dynamic_slice_in_dim(q, start, CHUNK, axis=1)
        kb = lax.dynamic_slice_in_dim(k_pad, start, BAND, axis=1)
        vb = lax.dynamic_slice_in_dim(v_pad, start, BAND, axis=1)
        s = jnp.einsum('bqhd,bkhd->bhqk', qb, kb).astype(jnp.float32) * sm_scale + bias[None]
        valid = (start + band_pos) >= 0
        s = jnp.where(valid[None, None, None, :], s, -jnp.inf)
        p = jax.nn.softmax(s, axis=-1)
        return jnp.einsum('bhqk,bkhd->bqhd', p.astype(vb.dtype), vb)

    out = lax.map(one_chunk, jnp.arange(n_chunks))
    return out.transpose(1, 0, 2, 3, 4).reshape(B, S, H * Dh)


def setup_inputs(seed: int = 0) -> dict:
    key = jax.random.key(seed)
    ks = jax.random.split(key, 20)
    D, E, Gw = D_MODEL, D_INNER, POOL_GROUP_W
    nrm = jax.random.normal
    return {
        "x": nrm(ks[0], (BATCH, SEQ, D), jnp.float32),
        "c": nrm(ks[1], (BATCH, D), jnp.float32),
        "ada_w": nrm(ks[2], (DEPTH, D, 3 * D), jnp.float32) * D ** -0.5,
        "ada_b": 0.01 * nrm(ks[3], (DEPTH, 3 * D), jnp.float32),
        "norm_g": 1.0 + 0.05 * nrm(ks[4], (DEPTH, D), jnp.float32),
        "a_w_in": nrm(ks[5], (N_A_LAYERS, D, 2 * E), jnp.float32) * D ** -0.5,
        "a_w_group": nrm(ks[6], (N_A_LAYERS, N_POOL_GROUPS, Gw, Gw), jnp.float32) * Gw ** -0.5,
        "a_scale": 1.0 + 0.1 * nrm(ks[7], (N_A_LAYERS, E), jnp.float32),
        "a_w_out": nrm(ks[8], (N_A_LAYERS, E, D), jnp.float32) * E ** -0.5,
        "kv_norm_g": 1.0 + 0.05 * nrm(ks[9], (D,), jnp.float32),
        "kv_ada_w": nrm(ks[10], (D, 2 * D), jnp.float32) * D ** -0.5,
        "kv_ada_b": 0.01 * nrm(ks[11], (2 * D,), jnp.float32),
        "w_kv": nrm(ks[12], (D, 2 * E), jnp.float32) * D ** -0.5,
        "b_w_in": nrm(ks[13], (N_B_LAYERS, D, 2 * E), jnp.float32) * D ** -0.5,
        "b_rel_bias": 0.5 * nrm(ks[14], (N_B_LAYERS, N_HEADS, 2 * REL_CLIP + 1), jnp.float32),
        "b_w_out": nrm(ks[15], (N_B_LAYERS, E, D), jnp.float32) * E ** -0.5,
        "final_g": 1.0 + 0.05 * nrm(ks[16], (D,), jnp.float32),
    }


def reference(x, c, ada_w, ada_b, norm_g, a_w_in, a_w_group, a_scale, a_w_out,
              kv_norm_g, kv_ada_w, kv_ada_b, w_kv, b_w_in, b_rel_bias, b_w_out,
              final_g):
    B, S, _ = x.shape
    c_act = jax.nn.silu(c)
    h = x
    k = v = None
    for layer in range(DEPTH):
        shift, scale, gate = jnp.split(c_act @ ada_w[layer] + ada_b[layer], 3, axis=-1)
        u = modulate(rms_norm(h, norm_g[layer]), shift, scale)
        if layer < N_A_LAYERS:
            a = layer
            val, z = jnp.split(u @ a_w_in[a], 2, axis=-1)
            pooled = multiscale_pool(val).astype(val.dtype)
            mixed = jnp.einsum('bsgi,gio->bsgo', pooled, a_w_group[a]).reshape(B, S, D_INNER)
            mixed = mixed * a_scale[a]
            y = (mixed * jax.nn.silu(z)) @ a_w_out[a]
        else:
            if layer == N_A_LAYERS:
                kv_shift, kv_scale = jnp.split(c_act @ kv_ada_w + kv_ada_b, 2, axis=-1)
                hk = modulate(rms_norm(h, kv_norm_g), kv_shift, kv_scale)
                k, v = jnp.split(hk @ w_kv, 2, axis=-1)
                k = k.reshape(B, S, N_HEADS, HEAD_DIM)
                v = v.reshape(B, S, N_HEADS, HEAD_DIM)
            bi = layer - N_A_LAYERS
            qv, z = jnp.split(u @ b_w_in[bi], 2, axis=-1)
            q = qv.reshape(B, S, N_HEADS, HEAD_DIM)
            att = chunk_band_attention(q, k, v, b_rel_bias[bi])
            y = (att * jax.nn.silu(z)) @ b_w_out[bi]
        h = h + gate[:, None, :] * y
    return rms_norm(h, final_g)
```

```cpp
#include <hip/hip_runtime.h>
#include <hip/hip_cooperative_groups.h>
#include <cstdio>
#include <cstdint>
namespace cg = cooperative_groups;
__device__ __forceinline__ int opaque_tid() { int t = threadIdx.x; asm volatile("" : "+v"(t)); return t; }
namespace pg8 {
#define PG8_LAS __attribute__((address_space(3)))
typedef unsigned short bf16_t;
typedef short bf16x8 __attribute__((ext_vector_type(8)));
typedef float f32x4 __attribute__((ext_vector_type(4)));
typedef unsigned u32x4 __attribute__((ext_vector_type(4)));
constexpr int BM = 256, BK = 64, HALF = 128, HTB = HALF * BK * 2  , STAGE_BYTES = 8 * HTB, NXCD = 8, WGM = 8;

__host__ __device__ __forceinline__ int lds_byte(int r, int c) { const int st = (r >> 4) * 2 + (c >> 5), rr = r & 15, cc = c & 31, ob = rr * 64 + cc * 2; return st * 1024 + (ob ^ (((ob >> 9) & 1) << 5)); }
__host__ __device__ __forceinline__ void stage_rc(int b, int& R, int& C) { const int st = b / 1024, sb = b % 1024, swz = sb ^ (((sb >> 9) & 1) << 5); R = (st >> 1) * 16 + swz / 64; C = (st & 1) * 32 + (swz % 64) / 2; }
__host__ __device__ __forceinline__ int perm32(int rho) { const int n = rho >> 4, i = rho & 15; return 8 * (i >> 2) + 4 * n + (i & 3); }

struct Unit { int pm, pn; };
struct Gemm { const bf16_t* A; const bf16_t* Bt; int M, N, K; };

struct StaticOrder {
    int nM, nN, nwg, G, c;
    __host__ __device__ void init(int M, int N, int G_, int c_) { nM = M / BM; nN = N / BM; nwg = nM * nN; G = G_; c = c_; }
    __host__ __device__ bool next(int i, Unit& u) const {
        const long L = (long)i * G + c; if (L >= nwg) return false;
        int wgid = (int)L; { const int q = nwg / NXCD, r = nwg % NXCD, xcd = wgid % NXCD, off = wgid / NXCD; wgid = (xcd < r ? xcd * (q + 1) : r * (q + 1) + (xcd - r) * q) + off; }
        const int nig = WGM * nN, gid = wgid / nig, fm = gid * WGM, gsz = (nM - fm) < WGM ? (nM - fm) : WGM;
        u.pm = fm + ((wgid % nig) % gsz); u.pn = (wgid % nig) / gsz; return true;
    }
    __device__ __forceinline__ void a_ready(const Unit&) const {}
    __device__ __forceinline__ void done(const Unit&) const {}
};
__device__ __forceinline__ unsigned cvt_pk_bf16(float lo, float hi) { unsigned r; asm volatile("v_cvt_pk_bf16_f32 %0, %1, %2" : "=v"(r) : "v"(lo), "v"(hi)); return r; }

__device__ __forceinline__ float silu_f(float v) { return v * __builtin_amdgcn_rcpf(1.0f + __builtin_amdgcn_exp2f(-1.4426950408889634f * v)); }
__device__ __forceinline__ float bf_lo(unsigned w) { return __uint_as_float(w << 16); }
__device__ __forceinline__ float bf_hi(unsigned w) { return __uint_as_float(w & 0xffff0000u); }

struct EpiIn {
    static constexpr bool PERM = true, AFTER_DRAIN = false;
    bf16_t* O0; bf16_t* O1; const float* ssq; const float* sw; int N; float scale0; int silu1; int mulin;
    __device__ __forceinline__ void operator()(const f32x4 (&acc)[2][2][4][2], const Unit& u, int wr, int wc, int fr, int fq) const {
        const int row0 = u.pm * BM + wr * 64 + fr; const int half = u.pn >= 8;
        bf16_t* base = half ? O1 : O0; const int colt = (u.pn & 7) * BM;
        const int col0 = colt + wc * 32 + 8 * fq, bcol0 = u.pn * BM + wc * 32 + 8 * fq;
        const float* swb = sw + (size_t)(u.pm >> 5) * N + bcol0;
        f32x4 bv[2][2];
#pragma unroll
        for (int bj = 0; bj < 2; ++bj)
#pragma unroll
            for (int n = 0; n < 2; ++n) bv[bj][n] = *(const f32x4*)(swb + bj * HALF + 4 * n);
#pragma unroll
        for (int ai = 0; ai < 2; ++ai)
#pragma unroll
            for (int m = 0; m < 4; ++m) {
                const int row = row0 + ai * HALF + m * 16;
                const f32x4* sp = (const f32x4*)(ssq + (size_t)row * 16);
                const f32x4 s0 = sp[0], s1 = sp[1], s2 = sp[2], s3 = sp[3];
                const f32x4 st = (s0 + s1) + (s2 + s3);
                const float rstd = __builtin_amdgcn_rsqf(((st[0] + st[1]) + (st[2] + st[3])) * (1.0f / 1024.0f) + 1e-6f);
                bf16_t* rowp = base + (size_t)row * 2048 + col0;
#pragma unroll
                for (int bj = 0; bj < 2; ++bj) {
                    f32x4 v0 = acc[ai][bj][m][0] * rstd + bv[bj][0], v1 = acc[ai][bj][m][1] * rstd + bv[bj][1];
                    if (mulin) {
                        const u32x4 a = *(const u32x4*)(rowp + bj * HALF);
#pragma unroll
                        for (int j = 0; j < 4; ++j) { v0[j] = silu_f(v0[j]); v1[j] = silu_f(v1[j]); }
                        v0[0] *= bf_lo(a.x); v0[1] *= bf_hi(a.x); v0[2] *= bf_lo(a.y); v0[3] *= bf_hi(a.y);
                        v1[0] *= bf_lo(a.z); v1[1] *= bf_hi(a.z); v1[2] *= bf_lo(a.w); v1[3] *= bf_hi(a.w);
                    } else if (half) {
                        if (silu1) {
#pragma unroll
                            for (int j = 0; j < 4; ++j) { v0[j] = silu_f(v0[j]); v1[j] = silu_f(v1[j]); }
                        }
                    } else { v0 *= scale0; v1 *= scale0; }
                    u32x4 w; w.x = cvt_pk_bf16(v0[0], v0[1]); w.y = cvt_pk_bf16(v0[2], v0[3]); w.z = cvt_pk_bf16(v1[0], v1[1]); w.w = cvt_pk_bf16(v1[2], v1[3]);
                    *(u32x4*)(rowp + bj * HALF) = w;
                }
            }
    }
};

struct EpiFold {
    static constexpr bool PERM = true, AFTER_DRAIN = false;
    bf16_t* W0; bf16_t* W1;
    __device__ __forceinline__ void operator()(const f32x4 (&acc)[2][2][4][2], const Unit& u, int wr, int wc, int fr, int fq) const {
        bf16_t* base = (u.pm >> 3) ? W1 : W0;
        const int row0 = (u.pm & 7) * BM + wr * 64 + fr, col0 = (u.pn & 3) * BM + wc * 32 + 8 * fq;
#pragma unroll
        for (int ai = 0; ai < 2; ++ai)
#pragma unroll
            for (int m = 0; m < 4; ++m) {
                bf16_t* rowp = base + (size_t)(row0 + ai * HALF + m * 16) * 1024 + col0;
#pragma unroll
                for (int bj = 0; bj < 2; ++bj) {
                    const f32x4 v0 = acc[ai][bj][m][0], v1 = acc[ai][bj][m][1];
                    u32x4 w; w.x = cvt_pk_bf16(v0[0], v0[1]); w.y = cvt_pk_bf16(v0[2], v0[3]); w.z = cvt_pk_bf16(v1[0], v1[1]); w.w = cvt_pk_bf16(v1[2], v1[3]);
                    *(u32x4*)(rowp + bj * HALF) = w;
                }
            }
    }
};

struct EpiOut {
    static constexpr bool PERM = true, AFTER_DRAIN = false;
    const float* hin; float* hout; const float* gate; int gate_bstride; float* ssq; const float* gsN; bf16_t* ubN; const float* gsK; bf16_t* ubK;
    __device__ __forceinline__ void operator()(const f32x4 (&acc)[2][2][4][2], const Unit& u, int wr, int wc, int fr, int fq) const {
        const int row0 = u.pm * BM + wr * 64 + fr, col0 = u.pn * BM + wc * 32 + 8 * fq, b = u.pm >> 5;
        float ss[8];
#pragma unroll
        for (int i = 0; i < 8; ++i) ss[i] = 0.f;
#pragma unroll
        for (int bj = 0; bj < 2; ++bj) {
            const int c = col0 + bj * HALF;
            const f32x4 g0 = *(const f32x4*)(gate + (size_t)b * gate_bstride + c), g1 = *(const f32x4*)(gate + (size_t)b * gate_bstride + c + 4);
#pragma unroll
            for (int ai = 0; ai < 2; ++ai)
#pragma unroll
                for (int m = 0; m < 4; ++m) {
                    const size_t off = (size_t)(row0 + ai * HALF + m * 16) * 1024 + c;
                    const f32x4 h0 = *(const f32x4*)(hin + off), h1 = *(const f32x4*)(hin + off + 4);
                    const f32x4 y0 = h0 + g0 * acc[ai][bj][m][0], y1 = h1 + g1 * acc[ai][bj][m][1];
                    *(f32x4*)(hout + off) = y0; *(f32x4*)(hout + off + 4) = y1;
                    ss[ai * 4 + m] += ((y0[0] * y0[0] + y0[1] * y0[1]) + (y0[2] * y0[2] + y0[3] * y0[3])) + ((y1[0] * y1[0] + y1[1] * y1[1]) + (y1[2] * y1[2] + y1[3] * y1[3]));
                    if (ubN) { const f32x4 n0 = *(const f32x4*)(gsN + b * 1024 + c), n1 = *(const f32x4*)(gsN + b * 1024 + c + 4); const f32x4 a0 = y0 * n0, a1 = y1 * n1; u32x4 w; w.x = cvt_pk_bf16(a0[0], a0[1]); w.y = cvt_pk_bf16(a0[2], a0[3]); w.z = cvt_pk_bf16(a1[0], a1[1]); w.w = cvt_pk_bf16(a1[2], a1[3]); *(u32x4*)(ubN + off) = w; }
                    if (ubK) { const f32x4 k0 = *(const f32x4*)(gsK + b * 1024 + c), k1 = *(const f32x4*)(gsK + b * 1024 + c + 4); const f32x4 a0 = y0 * k0, a1 = y1 * k1; u32x4 w; w.x = cvt_pk_bf16(a0[0], a0[1]); w.y = cvt_pk_bf16(a0[2], a0[3]); w.z = cvt_pk_bf16(a1[0], a1[1]); w.w = cvt_pk_bf16(a1[2], a1[3]); *(u32x4*)(ubK + off) = w; }
                    __builtin_amdgcn_sched_barrier(0);
                }
        }
#pragma unroll
        for (int ai = 0; ai < 2; ++ai)
#pragma unroll
            for (int m = 0; m < 4; ++m) {
                float s = ss[ai * 4 + m]; s += __shfl_xor(s, 16); s += __shfl_xor(s, 32);
                if (fq == 0) ssq[(size_t)(row0 + ai * HALF + m * 16) * 16 + u.pn * 4 + wc] = s;
            }
    }
};

struct FoldOrder {
    int G, c;
    __device__ bool next(int i, Unit& u) const { const int L = i * G + c; if (L >= 64) return false; u.pm = L >> 2; u.pn = (u.pm >> 1) * 4 + (L & 3); return true; }
    __device__ __forceinline__ void a_ready(const Unit&) const {}
    __device__ __forceinline__ void done(const Unit&) const {}
};
template <class Epi, class Sched, bool STAMP = false>
__device__ __forceinline__ void gemm_phase(PG8_LAS unsigned char* lds, const Gemm g, const Sched& S, const Epi& E, unsigned long long* stamps) {
    const int tid = opaque_tid(), wid = __builtin_amdgcn_readfirstlane(tid >> 6), lane = tid & 63, wr = wid >> 2, wc = wid & 3, fr = lane & 15, fq = lane >> 4;
    const int K = g.K, nt = K / BK;
    int ts_lo = 0, ts_hi = 0, nts = 0; const unsigned long long rt_entry = STAMP ? (unsigned long long)wall_clock64() : 0ull;
#define PG8_STAMP() do { if (STAMP && wid == 0 && nts < 64) { const unsigned long long _c = (unsigned long long)clock64(); \
        ts_lo = (lane == nts) ? (int)(unsigned)_c : ts_lo; ts_hi = (lane == nts) ? (int)(unsigned)(_c >> 32) : ts_hi; ++nts; } } while (0)
    PG8_STAMP();
    unsigned voffA[2], voffB[2];
#pragma unroll
    for (int i = 0; i < 2; ++i) { int R, C; stage_rc(tid * 16 + i * 8192, R, C); const int Rb = Epi::PERM ? ((R & ~31) + perm32(R & 31)) : R;
        voffA[i] = (unsigned)(R * K + C) * 2u; voffB[i] = (unsigned)(Rb * K + C) * 2u; }
    const size_t kstep = (size_t)(BK * 2);
    const size_t hstep = (size_t)HALF * K * 2;
    const size_t tstep = 2 * hstep;
    const unsigned ldsw = (unsigned)wid * 1024u;
    const int aoff = lds_byte(wr * 64 + fr, fq * 8), boff = lds_byte(wc * 32 + fr, fq * 8);
#define PG8_SA(b, h) (((b) * 2 + (h)) * HTB)
#define PG8_SB(b, h) ((4 + (b) * 2 + (h)) * HTB)
#define PG8_STAGE(bufoff, gbase, voff) do { _Pragma("unroll") for (int _i = 0; _i < 2; ++_i) \
        __builtin_amdgcn_global_load_lds((const unsigned*)((const char*)(gbase) + (voff)[_i]), (PG8_LAS unsigned*)(lds + (bufoff) + ldsw + _i * 8192), 16, 0, 0); } while (0)
#define PG8_LDA(dst, b, h) do { _Pragma("unroll") for (int m = 0; m < 4; ++m) _Pragma("unroll") for (int k = 0; k < 2; ++k) dst[m][k] = *(const PG8_LAS bf16x8*)(lds + PG8_SA(b, h) + aoff + m * 2048 + k * 1024); } while (0)
#define PG8_LDB(dst, b, h) do { _Pragma("unroll") for (int n = 0; n < 2; ++n) _Pragma("unroll") for (int k = 0; k < 2; ++k) dst[n][k] = *(const PG8_LAS bf16x8*)(lds + PG8_SB(b, h) + boff + n * 2048 + k * 1024); } while (0)
#define PG8_MMA(ai, bj, At, Bt) do { __builtin_amdgcn_s_setprio(1); _Pragma("unroll") for (int m = 0; m < 4; ++m) _Pragma("unroll") for (int n = 0; n < 2; ++n) _Pragma("unroll") for (int k = 0; k < 2; ++k) \
        acc[ai][bj][m][n] = __builtin_amdgcn_mfma_f32_16x16x32_bf16(Bt[n][k], At[m][k], acc[ai][bj][m][n], 0, 0, 0); __builtin_amdgcn_s_setprio(0); } while (0)
#define PG8_WAIT_V(n) asm volatile("s_waitcnt vmcnt(" #n ")" ::: "memory")
#define PG8_WAIT_L(n) asm volatile("s_waitcnt lgkmcnt(" #n ")" ::: "memory")
#define PG8_BAR __builtin_amdgcn_s_barrier()
#define PG8_SCHED __builtin_amdgcn_sched_barrier(0)
    Unit cur, nxt; int ui = 0;
    if (!S.next(0, cur)) return;
    f32x4 acc[2][2][4][2];
#pragma unroll
    for (int a = 0; a < 2; ++a)
#pragma unroll
        for (int b = 0; b < 2; ++b)
#pragma unroll
            for (int m = 0; m < 4; ++m)
#pragma unroll
                for (int n = 0; n < 2; ++n) acc[a][b][m][n] = (f32x4){0.f, 0.f, 0.f, 0.f};
    bf16x8 At[4][2], B0[2][2], B1[2][2];
    const char* cA = (const char*)g.A + (size_t)cur.pm * tstep; const char* cB = (const char*)g.Bt + (size_t)cur.pn * tstep;
    S.a_ready(cur);
    PG8_STAGE(PG8_SB(0, 0), cB, voffB); PG8_STAGE(PG8_SA(0, 0), cA, voffA); PG8_STAGE(PG8_SB(0, 1), cB + hstep, voffB); PG8_STAGE(PG8_SA(0, 1), cA + hstep, voffA);
    if (wr == 1) PG8_BAR;
    PG8_WAIT_V(4); PG8_BAR;
    PG8_STAGE(PG8_SB(1, 0), cB + kstep, voffB); PG8_STAGE(PG8_SA(1, 0), cA + kstep, voffA); PG8_STAGE(PG8_SB(1, 1), cB + hstep + kstep, voffB);
    PG8_WAIT_V(6); PG8_BAR;
    PG8_STAMP();
    for (;;) {
        const bool has_next = S.next(ui + 1, nxt);
        const char* nA = has_next ? (const char*)g.A + (size_t)nxt.pm * tstep : cA; const char* nB = has_next ? (const char*)g.Bt + (size_t)nxt.pn * tstep : cB;
        for (int t = 0; t < nt; t += 2) {
            const bool last = (t == nt - 2);
            const char* a1 = cA + (size_t)(t + 1) * kstep;
            const char* a2 = last ? nA : cA + (size_t)(t + 2) * kstep; const char* b2 = last ? nB : cB + (size_t)(t + 2) * kstep;
            const char* a3 = a2 + kstep; const char* b3 = b2 + kstep;
            if (last && has_next) S.a_ready(nxt);
            PG8_LDB(B0, 0, 0); PG8_SCHED; PG8_LDA(At, 0, 0); PG8_STAGE(PG8_SA(1, 1), a1 + hstep, voffA);
            PG8_WAIT_L(8); PG8_BAR; PG8_WAIT_L(0); PG8_MMA(0, 0, At, B0); PG8_BAR; PG8_SCHED;
            PG8_LDB(B1, 0, 1); PG8_STAGE(PG8_SB(0, 0), b2, voffB);
            PG8_BAR; PG8_WAIT_L(0); PG8_MMA(0, 1, At, B1); PG8_BAR;
            PG8_LDA(At, 0, 1); PG8_STAGE(PG8_SA(0, 0), a2, voffA);
            PG8_BAR; PG8_WAIT_L(0); PG8_MMA(1, 0, At, B0); PG8_BAR; PG8_SCHED;
            PG8_STAGE(PG8_SB(0, 1), b2 + hstep, voffB);
            PG8_WAIT_V(6); PG8_BAR; PG8_MMA(1, 1, At, B1); PG8_BAR;
            PG8_LDB(B0, 1, 0); PG8_SCHED; PG8_LDA(At, 1, 0); PG8_STAGE(PG8_SA(0, 1), a2 + hstep, voffA);
            PG8_WAIT_L(8); PG8_BAR; PG8_WAIT_L(0); PG8_MMA(0, 0, At, B0); PG8_BAR; PG8_SCHED;
            PG8_LDB(B1, 1, 1); PG8_STAGE(PG8_SB(1, 0), b3, voffB);
            PG8_BAR; PG8_WAIT_L(0); PG8_MMA(0, 1, At, B1); PG8_BAR;
            PG8_LDA(At, 1, 1); PG8_STAGE(PG8_SA(1, 0), a3, voffA);
            PG8_BAR; PG8_WAIT_L(0); PG8_MMA(1, 0, At, B0); PG8_BAR; PG8_SCHED;
            PG8_STAGE(PG8_SB(1, 1), b3 + hstep, voffB);
            PG8_WAIT_V(6); PG8_BAR; PG8_MMA(1, 1, At, B1); PG8_BAR;
        }
        PG8_STAMP();
        if constexpr (!Epi::AFTER_DRAIN) { E(acc, cur, wr, wc, fr, fq); S.done(cur); }
        PG8_STAMP();
        if (!has_next) break;
#pragma unroll
        for (int a = 0; a < 2; ++a)
#pragma unroll
            for (int b = 0; b < 2; ++b)
#pragma unroll
                for (int m = 0; m < 4; ++m)
#pragma unroll
                    for (int n = 0; n < 2; ++n) acc[a][b][m][n] = (f32x4){0.f, 0.f, 0.f, 0.f};
        cur = nxt; cA = nA; cB = nB; ++ui;
    }
    PG8_WAIT_V(0);
    if (wr == 0) PG8_BAR;
    PG8_BAR;
    if constexpr (Epi::AFTER_DRAIN) { E.fused(acc, cur, wr, wc, fr, fq, lds, wid, lane); S.done(cur); }
    PG8_STAMP();
    if (STAMP && wid == 0) { stamps[lane] = lane < nts ? (((unsigned long long)(unsigned)ts_hi << 32) | (unsigned)ts_lo) : 0ull;
        if (lane == 62) stamps[62] = rt_entry; if (lane == 63) stamps[63] = (unsigned long long)wall_clock64(); }
#undef PG8_STAMP
#undef PG8_SA
#undef PG8_SB
#undef PG8_STAGE
#undef PG8_LDA
#undef PG8_LDB
#undef PG8_MMA
#undef PG8_WAIT_V
#undef PG8_WAIT_L
#undef PG8_BAR
#undef PG8_SCHED
}
}

typedef unsigned short bf16_t;
typedef short bf16x8 __attribute__((ext_vector_type(8)));
typedef short s16x4 __attribute__((ext_vector_type(4)));
typedef float f32x4 __attribute__((ext_vector_type(4)));
typedef float f32x16 __attribute__((ext_vector_type(16)));
typedef unsigned u32x4 __attribute__((ext_vector_type(4)));
constexpr int MTOK = 32768, DM = 1024, EI = 2048, SEQ = 8192, NB = 4, NH = 16;
constexpr float LOG2E = 1.4426950408889634f;
constexpr float QSCALE = 0.088388347648318440f * LOG2E;
constexpr int LDS_BYTES = 131072;
#ifndef PHMASK
#define PHMASK 0xffff
#endif
#define PH(b) ((PHMASK >> (b)) & 1)
constexpr size_t MiB = 1024 * 1024;
constexpr size_t WS_R0 = 0;
constexpr size_t WS_R1 = 128 * MiB;
constexpr size_t WS_R2 = 256 * MiB;
constexpr size_t WS_UB = 384 * MiB;
constexpr size_t WS_WT = 448 * MiB;
constexpr size_t WT_IN = WS_WT, WT_OUT = WT_IN + 2 * 8 * MiB, WT_KV = WT_OUT + 2 * 4 * MiB, WT_BIN = WT_KV + 8 * MiB, WT_BOUT = WT_BIN + 2 * 8 * MiB;
constexpr size_t WS_SSQ = WT_BOUT + 2 * 4 * MiB;
constexpr size_t WS_MOD = WS_SSQ + 2 * MiB;
constexpr size_t MOD_BYTES = (4 * 4 * 3072 + 4 * 2048) * 4;
constexpr size_t WS_GS = WS_MOD + 256 * 1024;
constexpr size_t WS_SW = WS_GS + 128 * 1024;
constexpr size_t WS_END = WS_SW + 512 * 1024;
constexpr size_t WS_WGT = WS_R2;
constexpr size_t WS_BFOLD = WS_R2 + 4 * MiB;
static_assert(WS_END <= 512 * MiB, "workspace");

struct Params {
    const float* x; const float* c; const float* ada_w; const float* ada_b; const float* norm_g; const float* a_w_in; const float* a_w_group; const float* a_scale; const float* a_w_out;
    const float* kv_norm_g; const float* kv_ada_w; const float* kv_ada_b; const float* w_kv; const float* b_w_in; const float* b_rel_bias; const float* b_w_out; const float* final_g;
    float* out; unsigned char* ws;
};

__device__ __forceinline__ unsigned cvtpk(float lo, float hi) { unsigned r; asm volatile("v_cvt_pk_bf16_f32 %0, %1, %2" : "=v"(r) : "v"(lo), "v"(hi)); return r; }
__device__ __forceinline__ float bflo(unsigned w) { return __uint_as_float(w << 16); }
__device__ __forceinline__ float bfhi(unsigned w) { return __uint_as_float(w & 0xffff0000u); }
__device__ __forceinline__ float wave_sum(float v) {
#pragma unroll
    for (int o = 32; o >= 1; o >>= 1) v += __shfl_xor(v, o);
    return v;
}

namespace att {
#define KSWZ(row, colB) ((row) * 256 + ((colB) ^ (((row) & 7) << 4)))
#define SBAR() __builtin_amdgcn_sched_barrier(0)
__device__ __forceinline__ int crow(int r, int hi) { return (r & 3) + 8 * (r >> 2) + 4 * hi; }
__device__ __forceinline__ void qkt(f32x16& p0, f32x16& p1, const char* Ks, const bf16x8* qr, int r32, int hi) {
    p0 = f32x16{}; p1 = f32x16{};
#pragma unroll
    for (int d0 = 0; d0 < 8; ++d0) { const int cb = (d0 * 16 + hi * 8) * 2;
        const bf16x8 b0 = *reinterpret_cast<const bf16x8*>(Ks + KSWZ(r32, cb));
        const bf16x8 b1 = *reinterpret_cast<const bf16x8*>(Ks + KSWZ(32 + r32, cb));
        p0 = __builtin_amdgcn_mfma_f32_32x32x16_bf16(b0, qr[d0], p0, 0, 0, 0);
        p1 = __builtin_amdgcn_mfma_f32_32x32x16_bf16(b1, qr[d0], p1, 0, 0, 0); }
}
__device__ __forceinline__ int v_st(int k, int c) { const int kk = (k & ~0xC) | ((k & 4) << 1) | ((k & 8) >> 1); return ((kk >> 3) * 4 + (c >> 5)) * 512 + ((kk & 7) * 32 + (c & 31)) * 2; }
__device__ __forceinline__ int v_rd_base(int lane) { return ((lane & 3) << 3) | (((lane >> 2) & 3) << 6) | (((lane >> 4) & 1) << 5) | (((lane >> 5) & 1) << 8); }
constexpr int v_rd_off(int d0, int ks, int half) { return d0 * 512 + ks * 4096 + half * 2048; }
template <int OFF> __device__ __forceinline__ s16x4 tr_read(int vb) {
    s16x4 r; asm volatile("ds_read_b64_tr_b16 %0, %1 offset:%2" : "=&v"(r) : "v"(vb), "i"(OFF) : "memory"); return r;
}
template <int D0> __device__ __forceinline__ void pv_one(f32x16& od, int vb, bf16x8 pa0, bf16x8 pa1, bf16x8 pa2, bf16x8 pa3) {
    const s16x4 l0 = tr_read<v_rd_off(D0, 0, 0)>(vb), h0 = tr_read<v_rd_off(D0, 0, 1)>(vb), l1 = tr_read<v_rd_off(D0, 1, 0)>(vb), h1 = tr_read<v_rd_off(D0, 1, 1)>(vb);
    const s16x4 l2 = tr_read<v_rd_off(D0, 2, 0)>(vb), h2 = tr_read<v_rd_off(D0, 2, 1)>(vb), l3 = tr_read<v_rd_off(D0, 3, 0)>(vb), h3 = tr_read<v_rd_off(D0, 3, 1)>(vb);
    asm volatile("s_waitcnt lgkmcnt(0)" ::: "memory"); SBAR();
#define PK(L, H) (bf16x8){L[0], L[1], L[2], L[3], H[0], H[1], H[2], H[3]}
    od = __builtin_amdgcn_mfma_f32_32x32x16_bf16(pa0, PK(l0, h0), od, 0, 0, 0);
    od = __builtin_amdgcn_mfma_f32_32x32x16_bf16(pa1, PK(l1, h1), od, 0, 0, 0);
    od = __builtin_amdgcn_mfma_f32_32x32x16_bf16(pa2, PK(l2, h2), od, 0, 0, 0);
    od = __builtin_amdgcn_mfma_f32_32x32x16_bf16(pa3, PK(l3, h3), od, 0, 0, 0);
#undef PK
}
constexpr float THR2 = 11.0f;

__device__ __forceinline__ void attn_phase(char* lds, bf16_t* Qio, const bf16_t* Kb, const bf16_t* Vb, const float* relb, int vcu, int G) {
    const int tid = opaque_tid(), wid = __builtin_amdgcn_readfirstlane(tid >> 6), lane = tid & 63, r32 = lane & 31, hi = lane >> 5;
    char* V_lds = lds; char* K_lds = lds + 32768;
    float* wsf = (float*)(lds + 65536) + wid * 64; float* li_l = wsf; float* al_l = wsf + 32;
    float* tb = (float*)(lds + 65536 + 2048);
    const int sr = tid >> 4, sc = (tid & 15) * 8, vst0 = v_st(sr, sc), vst1 = v_st(32 + sr, sc);
    const int vb0 = (int)(uintptr_t)V_lds + v_rd_base(lane);
    const int ci = wid >> 1, qrow = (wid & 1) * 32 + r32;
    for (int it = vcu; it < 2048; it += G) {
        const int cgp = it & 31, bh = it >> 5, h = bh & 15, b = bh >> 4, c0 = cgp * 4;
        if (tid < 257) tb[tid] = relb[h * 257 + tid] * LOG2E;
        bf16_t* Qw = Qio + ((size_t)(b * SEQ + c0 * 64 + wid * 32) * EI + h * 128);
        const bf16_t* Kh = Kb + (size_t)(b * SEQ) * EI + h * 128; const bf16_t* Vh = Vb + (size_t)(b * SEQ) * EI + h * 128;
        bf16x8 qr[8];
#pragma unroll
        for (int d0 = 0; d0 < 8; ++d0) qr[d0] = *(const bf16x8*)(Qw + (size_t)r32 * EI + hi * 8 + d0 * 16);
        float m_reg = -1e30f, l_reg = 0.f; f32x16 o[4] = {};
        bf16x8 vs0, vs1, ks0, ks1;
#define SLOAD(k0) do { vs0 = *(const bf16x8*)(Vh + (size_t)((k0) + sr) * EI + sc); vs1 = *(const bf16x8*)(Vh + (size_t)((k0) + 32 + sr) * EI + sc); \
        ks0 = *(const bf16x8*)(Kh + (size_t)((k0) + sr) * EI + sc); ks1 = *(const bf16x8*)(Kh + (size_t)((k0) + 32 + sr) * EI + sc); } while (0)
#define SWRITE(bb) do { *(bf16x8*)(V_lds + (bb) * 16384 + vst0) = vs0; *(bf16x8*)(V_lds + (bb) * 16384 + vst1) = vs1; const int kc = sc * 2; \
        *(bf16x8*)(K_lds + (bb) * 16384 + KSWZ(sr, kc)) = ks0; *(bf16x8*)(K_lds + (bb) * 16384 + KSWZ(32 + sr, kc)) = ks1; } while (0)
        const int jstart = (8 - c0) > 0 ? (8 - c0) : 0;
        SLOAD((c0 - 8 + jstart) * 64); asm volatile("s_waitcnt vmcnt(0)" ::: "memory"); SWRITE(0);
        SLOAD((c0 - 8 + jstart + 1) * 64);
        __syncthreads();
        for (int j = jstart; j < 12; ++j) {
            const int buf = (j - jstart) & 1;
            if (j >= ci && j <= ci + 8) {
                const int dc = ci + 8 - j;
                f32x16 p0, p1;
                qkt(p0, p1, K_lds + buf * 16384, qr, r32, hi);
                if (dc >= 3) { const float cb = tb[256];
#pragma unroll
                    for (int r = 0; r < 16; ++r) { p0[r] += cb; p1[r] += cb; }
                } else {
                    const int base = 64 * dc + 128 + qrow;
#pragma unroll
                    for (int r = 0; r < 16; ++r) { int i0 = base - crow(r, hi), i1 = i0 - 32; i0 = i0 > 256 ? 256 : i0; i1 = i1 > 256 ? 256 : i1; p0[r] += tb[i0]; p1[r] += tb[i1]; }
                }
                float pmax = p0[0];
#pragma unroll
                for (int r = 1; r < 16; ++r) pmax = fmaxf(pmax, p0[r]);
#pragma unroll
                for (int r = 0; r < 16; ++r) pmax = fmaxf(pmax, p1[r]);
                { auto rr = __builtin_amdgcn_permlane32_swap(__float_as_uint(pmax), __float_as_uint(pmax), false, false);
                  pmax = fmaxf(__uint_as_float(rr[0]), __uint_as_float(rr[1])); }
                float mn, alpha;
                if (__all(pmax - m_reg <= THR2)) { mn = m_reg; alpha = 1.f; }
                else { mn = fmaxf(m_reg, pmax); alpha = __builtin_amdgcn_exp2f(m_reg - mn); m_reg = mn; }
#pragma unroll
                for (int r = 0; r < 16; ++r) { p0[r] = __builtin_amdgcn_exp2f(p0[r] - mn); p1[r] = __builtin_amdgcn_exp2f(p1[r] - mn); }
                float ps = 0.f;
#pragma unroll
                for (int r = 0; r < 16; ++r) ps += p0[r] + p1[r];
                { auto rr = __builtin_amdgcn_permlane32_swap(__float_as_uint(ps), __float_as_uint(ps), false, false);
                  ps = __uint_as_float(rr[0]) + __uint_as_float(rr[1]); }
                l_reg = l_reg * alpha + ps;
                if (__any(alpha < 1.f)) { if (hi == 0) al_l[r32] = alpha; asm volatile("s_waitcnt lgkmcnt(0)" ::: "memory");
#pragma unroll
                    for (int r = 0; r < 16; ++r) { const float a = al_l[crow(r, hi)];
#pragma unroll
                        for (int d = 0; d < 4; ++d) o[d][r] *= a; } }
                bf16x8 pa0, pa1, pa2, pa3;
#define PK4(P, BASE, OUT) do { unsigned a0 = cvtpk(P[BASE + 0], P[BASE + 1]), a1 = cvtpk(P[BASE + 2], P[BASE + 3]);   \
    unsigned b0 = cvtpk(P[BASE + 4], P[BASE + 5]), b1 = cvtpk(P[BASE + 6], P[BASE + 7]);                              \
    auto r0 = __builtin_amdgcn_permlane32_swap(a0, b0, false, false); auto r1 = __builtin_amdgcn_permlane32_swap(a1, b1, false, false); \
    u32x4 w = {r0[0], r1[0], r0[1], r1[1]}; OUT = *reinterpret_cast<bf16x8*>(&w); } while (0)
                PK4(p0, 0, pa0); PK4(p0, 8, pa1); PK4(p1, 0, pa2); PK4(p1, 8, pa3);
#undef PK4
                const int vb = vb0 + buf * 16384;
                pv_one<0>(o[0], vb, pa0, pa1, pa2, pa3); pv_one<1>(o[1], vb, pa0, pa1, pa2, pa3); pv_one<2>(o[2], vb, pa0, pa1, pa2, pa3); pv_one<3>(o[3], vb, pa0, pa1, pa2, pa3);
            }
            if (j + 1 < 12) { asm volatile("s_waitcnt vmcnt(0)" ::: "memory"); SWRITE(buf ^ 1); }
            if (j + 2 < 12) SLOAD((c0 - 8 + j + 2) * 64);
            __syncthreads();
        }
#undef SLOAD
#undef SWRITE
        if (hi == 0) li_l[r32] = l_reg; asm volatile("s_waitcnt lgkmcnt(0)" ::: "memory");
#pragma unroll
        for (int r = 0; r < 16; ++r) { const int orow = crow(r, hi); const float rl = __builtin_amdgcn_rcpf(li_l[orow]);
#pragma unroll
            for (int d0 = 0; d0 < 4; ++d0) { const unsigned w = cvtpk(o[d0][r] * rl, 0.f); Qw[(size_t)orow * EI + d0 * 32 + r32] = (bf16_t)(w & 0xffffu); } }
    }
}
}

__device__ __forceinline__ void p0_mod(const Params& P, char* lds, int bx) {
    float* cact = (float*)lds;
    const int tid = opaque_tid();
    if (bx >= 224) return;
    for (int i = tid; i < 4096; i += 512) { const float v = P.c[i]; cact[i] = v * __builtin_amdgcn_rcpf(1.0f + __builtin_amdgcn_exp2f(-LOG2E * v)); }
    __syncthreads();
    const int cb = bx >> 3, kc = bx & 7;
    const float* W; const float* bias; float* outp; int pitch, j0;
    float* mod = (float*)(P.ws + WS_MOD);
    if (cb < 24) { const int l = cb / 6; j0 = (cb % 6) * 512; W = P.ada_w + (size_t)l * 1024 * 3072; pitch = 3072; bias = P.ada_b + l * 3072; outp = mod + l * 4 * 3072; }
    else { j0 = (cb - 24) * 512; W = P.kv_ada_w; pitch = 2048; bias = P.kv_ada_b; outp = mod + 4 * 4 * 3072; }
    const int j = j0 + tid; float a0 = 0.f, a1 = 0.f, a2 = 0.f, a3 = 0.f;
    const float* wp = W + (size_t)(kc * 128) * pitch + j;
#pragma unroll 8
    for (int k = 0; k < 128; ++k) { const float w = wp[(size_t)k * pitch]; const int kk = kc * 128 + k; a0 += cact[kk] * w; a1 += cact[1024 + kk] * w; a2 += cact[2048 + kk] * w; a3 += cact[3072 + kk] * w; }
    if (kc == 0) { const float bb = bias[j]; a0 += bb; a1 += bb; a2 += bb; a3 += bb; }
    atomicAdd(outp + 0 * pitch + j, a0); atomicAdd(outp + 1 * pitch + j, a1); atomicAdd(outp + 2 * pitch + j, a2); atomicAdd(outp + 3 * pitch + j, a3);
    __syncthreads();
}

__device__ __forceinline__ void transpose_tile(const float* src, int spitch, bf16_t* dst, int dpitch, int r0, int c0, char* lds) {
    bf16_t* tile = (bf16_t*)lds;
    const int tid = opaque_tid();
    { const int rr = tid >> 4, c4 = (tid & 15) * 4;
#pragma unroll
      for (int p = 0; p < 4; ++p) { const int r = p * 32 + rr; const f32x4 v = *(const f32x4*)(src + (size_t)(r0 + r) * spitch + c0 + c4);
          const unsigned w0 = cvtpk(v[0], v[1]), w1 = cvtpk(v[2], v[3]);
          tile[(c4 + 0) * 136 + r] = (bf16_t)(w0 & 0xffffu); tile[(c4 + 1) * 136 + r] = (bf16_t)(w0 >> 16); tile[(c4 + 2) * 136 + r] = (bf16_t)(w1 & 0xffffu); tile[(c4 + 3) * 136 + r] = (bf16_t)(w1 >> 16); } }
    __syncthreads();
    { const int c = tid >> 4, r8 = (tid & 15) * 8;
#pragma unroll
      for (int p = 0; p < 2; ++p) { const int cc = p * 32 + c; const u32x4 w = *(const u32x4*)(tile + cc * 136 + r8); *(u32x4*)(dst + (size_t)(c0 + cc) * dpitch + r0 + r8) = w; } }
    __syncthreads();
}
__device__ __forceinline__ void p0_weights(const Params& P, char* lds, int bx, int G) {
    unsigned char* ws = P.ws;
    for (int t = bx; t < 3328; t += G) {
        const float* src; bf16_t* dst; int spitch, dpitch, ntc, tt;
        if (t < 512) { const int l = t >> 8; tt = t & 255; src = P.a_w_in + (size_t)l * 1024 * 4096 + 2048; spitch = 4096; dst = (bf16_t*)(ws + WT_IN + l * 8 * MiB) + (size_t)2048 * 1024; dpitch = 1024; ntc = 32; }
        else if (t < 1024) { const int l = (t - 512) >> 8; tt = t & 255; src = P.a_w_out + (size_t)l * 2048 * 1024; spitch = 1024; dst = (bf16_t*)(ws + WT_OUT + l * 4 * MiB); dpitch = 2048; ntc = 16; }
        else if (t < 1536) { tt = t - 1024; src = P.w_kv; spitch = 4096; dst = (bf16_t*)(ws + WT_KV); dpitch = 1024; ntc = 64; }
        else if (t < 2560) { const int l = (t - 1536) >> 9; tt = (t - 1536) & 511; src = P.b_w_in + (size_t)l * 1024 * 4096; spitch = 4096; dst = (bf16_t*)(ws + WT_BIN + l * 8 * MiB); dpitch = 1024; ntc = 64; }
        else if (t < 3072) { const int l = (t - 2560) >> 8; tt = t & 255; src = P.b_w_out + (size_t)l * 2048 * 1024; spitch = 1024; dst = (bf16_t*)(ws + WT_BOUT + l * 4 * MiB); dpitch = 2048; ntc = 16; }
        else { const int lg = (t - 3072) >> 5; tt = t & 31; src = P.a_w_group + (size_t)lg * 512 * 512; spitch = 512; dst = (bf16_t*)(ws + WS_WGT) + (size_t)lg * 512 * 512; dpitch = 512; ntc = 8; }
        const int tr = tt / ntc, tc = tt % ntc;
        transpose_tile(src, spitch, dst, dpitch, tr * 128, tc * 64, lds);
    }
    bf16_t* bf = (bf16_t*)(ws + WS_BFOLD);
    for (int i = bx * 512 + opaque_tid(); i < 2 * 4 * 1024 * 64; i += G * 512) {
        const int j8 = i & 63, k = (i >> 6) & 1023, lg = i >> 16, l = lg >> 2, g = lg & 3;
        const float* s = P.a_w_in + ((size_t)l * 1024 + k) * 4096 + g * 512 + j8 * 8;
        const f32x4 v0 = *(const f32x4*)s, v1 = *(const f32x4*)(s + 4);
        u32x4 w; w.x = cvtpk(v0[0], v0[1]); w.y = cvtpk(v0[2], v0[3]); w.z = cvtpk(v1[0], v1[1]); w.w = cvtpk(v1[2], v1[3]);
        *(u32x4*)(bf + (size_t)i * 8) = w;
    }
}

__device__ __forceinline__ void p1_gs(const Params& P) {
    const float* mod = (const float*)(P.ws + WS_MOD); float* gs = (float*)(P.ws + WS_GS);
    for (int i = opaque_tid(); i < 5 * 4096; i += 512) {
        const int idx = i >> 12, b = (i >> 10) & 3, c = i & 1023;
        const float g = idx < 4 ? P.norm_g[idx * 1024 + c] : P.kv_norm_g[c];
        const float sc = idx < 4 ? mod[(idx * 4 + b) * 3072 + 1024 + c] : mod[4 * 4 * 3072 + b * 2048 + 1024 + c];
        gs[i] = g * (1.0f + sc);
    }
}
__device__ __forceinline__ void p1_prep(const Params& P, int bx, int G) {
    const float* mod = (const float*)(P.ws + WS_MOD); float* ssq = (float*)(P.ws + WS_SSQ); bf16_t* ub = (bf16_t*)(P.ws + WS_UB);
    const int tid = opaque_tid(); const int wid = tid >> 6, lane = tid & 63;
    int curb = -1; f32x4 g[4];
    for (int row = bx * 8 + wid; row < MTOK; row += G * 8) {
        const int b = row >> 13;
        if (b != curb) { curb = b;
#pragma unroll
            for (int k = 0; k < 2; ++k)
#pragma unroll
                for (int q = 0; q < 2; ++q) { const int c = k * 512 + lane * 8 + q * 4; const f32x4 ng = *(const f32x4*)(P.norm_g + c), sc = *(const f32x4*)(mod + b * 3072 + 1024 + c); g[k * 2 + q] = ng * (1.0f + sc); } }
        float s = 0.f;
#pragma unroll
        for (int k = 0; k < 2; ++k) { const int c = k * 512 + lane * 8;
            const f32x4 v0 = *(const f32x4*)(P.x + (size_t)row * 1024 + c), v1 = *(const f32x4*)(P.x + (size_t)row * 1024 + c + 4);
            s += ((v0[0] * v0[0] + v0[1] * v0[1]) + (v0[2] * v0[2] + v0[3] * v0[3])) + ((v1[0] * v1[0] + v1[1] * v1[1]) + (v1[2] * v1[2] + v1[3] * v1[3]));
            const f32x4 a0 = v0 * g[k * 2], a1 = v1 * g[k * 2 + 1];
            u32x4 w; w.x = cvtpk(a0[0], a0[1]); w.y = cvtpk(a0[2], a0[3]); w.z = cvtpk(a1[0], a1[1]); w.w = cvtpk(a1[2], a1[3]);
            *(u32x4*)(ub + (size_t)row * 1024 + c) = w; }
        s = wave_sum(s);
        if (lane < 16) ssq[(size_t)row * 16 + lane] = lane == 0 ? s : 0.f;
    }
}
__device__ __forceinline__ void p2_sw(const Params& P, char* lds, int bx, int G) {
    float* sh = (float*)lds;
    const float* mod = (const float*)(P.ws + WS_MOD); float* sw = (float*)(P.ws + WS_SW);
    const int tid = opaque_tid(), wid = tid >> 6, lane = tid & 63;
    int curw = -1;
    for (int it = bx; it < 5 * 128; it += G) {
        const int widx = it >> 7, n0 = (it & 127) * 32;
        if (widx != curw) { curw = widx; __syncthreads();
            for (int i = tid; i < 4096; i += 512) { const int b = i >> 10, k = i & 1023;
                const int layer = widx < 2 ? widx : (widx < 4 ? widx : -1);
                sh[i] = widx < 4 ? mod[(layer * 4 + b) * 3072 + k] : mod[4 * 4 * 3072 + b * 2048 + k]; }
            __syncthreads(); }
        const bf16_t* Wt = (const bf16_t*)(P.ws + (widx < 2 ? WT_IN + widx * 8 * MiB : (widx < 4 ? WT_BIN + (widx - 2) * 8 * MiB : WT_KV)));
#pragma unroll 1
        for (int q = 0; q < 4; ++q) { const int n = n0 + wid * 4 + q;
            const u32x4 w0 = *(const u32x4*)(Wt + (size_t)n * 1024 + lane * 16), w1 = *(const u32x4*)(Wt + (size_t)n * 1024 + lane * 16 + 8);
            float wv[16] = {bflo(w0.x), bfhi(w0.x), bflo(w0.y), bfhi(w0.y), bflo(w0.z), bfhi(w0.z), bflo(w0.w), bfhi(w0.w), bflo(w1.x), bfhi(w1.x), bflo(w1.y), bfhi(w1.y), bflo(w1.z), bfhi(w1.z), bflo(w1.w), bfhi(w1.w)};
            float a[4];
#pragma unroll
            for (int b = 0; b < 4; ++b) { float s = 0.f;
#pragma unroll
                for (int k4 = 0; k4 < 4; ++k4) { const f32x4 sv = *(const f32x4*)(sh + b * 1024 + lane * 16 + k4 * 4); s += sv[0] * wv[k4 * 4] + sv[1] * wv[k4 * 4 + 1] + sv[2] * wv[k4 * 4 + 2] + sv[3] * wv[k4 * 4 + 3]; }
                a[b] = wave_sum(s); }
            if (lane == 0) { sw[(widx * 4 + 0) * 4096 + n] = a[0]; sw[(widx * 4 + 1) * 4096 + n] = a[1]; sw[(widx * 4 + 2) * 4096 + n] = a[2]; sw[(widx * 4 + 3) * 4096 + n] = a[3]; } }
    }
    __syncthreads();
}

__device__ __forceinline__ void pool_gate(char* lds, const bf16_t* vg, bf16_t* sz, const float* a_scale, int bx, int G) {
    const int tid = opaque_tid(), wid = tid >> 6, lane = tid & 63;
    for (int it = bx; it < 2048; it += G) {
        const int g = it & 3, rt = it >> 2, m0 = rt * 64, t0 = m0 & (SEQ - 1), w = 2 << g;
        __syncthreads();
        u32x4 st[10];
#pragma unroll
        for (int k = 0; k < 10; ++k) { const int p = tid + k * 512, lr = p >> 6, c16 = p & 63; u32x4 v = {0u, 0u, 0u, 0u};
            if (p < 79 * 64 && (t0 + lr - 15) >= 0) v = *(const u32x4*)(vg + (size_t)(m0 + lr - 15) * EI + g * 512 + c16 * 8);
            st[k] = v; }
#pragma unroll
        for (int k = 0; k < 10; ++k) { const int p = tid + k * 512; if (p < 79 * 64) *(u32x4*)(lds + (size_t)p * 16) = st[k]; }
        __syncthreads();
        const int e = g * 512 + lane * 8;
        const f32x4 as0 = *(const f32x4*)(a_scale + e), as1 = *(const f32x4*)(a_scale + e + 4);
        float ws8[8];
#pragma unroll
        for (int i = 0; i < 8; ++i) ws8[i] = 0.f;
        const int r0 = wid * 8;
        for (int k = 1; k < w; ++k) { const u32x4 v = *(const u32x4*)(lds + (size_t)(r0 + 15 - k) * 1024 + lane * 16);
            ws8[0] += bflo(v.x); ws8[1] += bfhi(v.x); ws8[2] += bflo(v.y); ws8[3] += bfhi(v.y); ws8[4] += bflo(v.z); ws8[5] += bfhi(v.z); ws8[6] += bflo(v.w); ws8[7] += bfhi(v.w); }
#pragma unroll 1
        for (int r = 0; r < 8; ++r) {
            const int lr = r0 + r + 15;
            const u32x4 v = *(const u32x4*)(lds + (size_t)lr * 1024 + lane * 16);
            const float x[8] = {bflo(v.x), bfhi(v.x), bflo(v.y), bfhi(v.y), bflo(v.z), bfhi(v.z), bflo(v.w), bfhi(v.w)};
#pragma unroll
            for (int i = 0; i < 8; ++i) ws8[i] += x[i];
            const int t = t0 + r0 + r; const int cnt = (t + 1) < w ? (t + 1) : w; const float inv = 1.0f / (float)cnt;
            const size_t off = (size_t)(m0 + r0 + r) * EI + e;
            const u32x4 z = *(const u32x4*)(sz + off);
            const float zz[8] = {bflo(z.x), bfhi(z.x), bflo(z.y), bfhi(z.y), bflo(z.z), bfhi(z.z), bflo(z.w), bfhi(z.w)};
            float o[8];
#pragma unroll
            for (int i = 0; i < 8; ++i) o[i] = (ws8[i] * inv - x[i]) * (i < 4 ? as0[i & 3] : as1[i & 3]) * zz[i];
            u32x4 wv; wv.x = cvtpk(o[0], o[1]); wv.y = cvtpk(o[2], o[3]); wv.z = cvtpk(o[4], o[5]); wv.w = cvtpk(o[6], o[7]);
            *(u32x4*)(sz + off) = wv;
            const u32x4 d = *(const u32x4*)(lds + (size_t)(lr - w + 1) * 1024 + lane * 16);
            ws8[0] -= bflo(d.x); ws8[1] -= bfhi(d.x); ws8[2] -= bflo(d.y); ws8[3] -= bfhi(d.y); ws8[4] -= bflo(d.z); ws8[5] -= bfhi(d.z); ws8[6] -= bflo(d.w); ws8[7] -= bfhi(d.w);
        }
    }
    __syncthreads();
}

__device__ __forceinline__ void final_norm(const Params& P, int bx, int G) {
    const float* ssq = (const float*)(P.ws + WS_SSQ);
    const int tid = opaque_tid(); const int wid = tid >> 6, lane = tid & 63;
    f32x4 g[4];
#pragma unroll
    for (int k = 0; k < 4; ++k) g[k] = *(const f32x4*)(P.final_g + k * 256 + lane * 4);
    for (int row = bx * 8 + wid; row < MTOK; row += G * 8) {
        const f32x4* sp = (const f32x4*)(ssq + (size_t)row * 16);
        const f32x4 st = (sp[0] + sp[1]) + (sp[2] + sp[3]);
        const float rstd = __builtin_amdgcn_rsqf(((st[0] + st[1]) + (st[2] + st[3])) * (1.0f / 1024.0f) + 1e-6f);
        float* hp = P.out + (size_t)row * 1024;
#pragma unroll
        for (int k = 0; k < 4; ++k) { const f32x4 v = *(const f32x4*)(hp + k * 256 + lane * 4); *(f32x4*)(hp + k * 256 + lane * 4) = v * rstd * g[k]; }
    }
}

__global__ void __launch_bounds__(512) yoco_fwd(Params P) {
    extern __shared__ __attribute__((aligned(16))) unsigned char smem[];
    cg::grid_group grid = cg::this_grid();
    const int G = gridDim.x, bx = blockIdx.x;
    const int vcu = (G % 8 == 0) ? (bx % 8) * (G / 8) + bx / 8 : bx;
    unsigned char* ws = P.ws;
    PG8_LAS unsigned char* lds3 = (PG8_LAS unsigned char*)smem;
    float* ssq = (float*)(ws + WS_SSQ); const float* mod = (const float*)(ws + WS_MOD); const float* gs = (const float*)(ws + WS_GS); const float* sw = (const float*)(ws + WS_SW);
    bf16_t* R0 = (bf16_t*)(ws + WS_R0); bf16_t* R1 = (bf16_t*)(ws + WS_R1); bf16_t* R2 = (bf16_t*)(ws + WS_R2); bf16_t* UB = (bf16_t*)(ws + WS_UB);

    if (PH(0)) { p0_mod(P, (char*)smem, bx);
    p0_weights(P, (char*)smem, bx, G); }
    grid.sync();
    if (PH(1)) { pg8::Gemm g{(const bf16_t*)(ws + WS_WGT), (const bf16_t*)(ws + WS_BFOLD), 4096, 8192, 512};
      pg8::FoldOrder S{G, bx}; pg8::EpiFold E{(bf16_t*)(ws + WT_IN), (bf16_t*)(ws + WT_IN + 8 * MiB)};
      pg8::gemm_phase<pg8::EpiFold, pg8::FoldOrder>(lds3, g, S, E, nullptr); }
    if (PH(2)) { if (bx == G - 1) p1_gs(P);
    p1_prep(P, bx, G); }
    grid.sync();
    if (PH(3)) p2_sw(P, (char*)smem, bx, G);
    grid.sync();

    for (int l = 0; l < 2; ++l) {
        if (PH(4)) { pg8::Gemm g{UB, (const bf16_t*)(ws + WT_IN + l * 8 * MiB), MTOK, 4096, 1024};
          pg8::StaticOrder S; S.init(MTOK, 4096, G, bx);
          pg8::EpiIn E{R0, R1, ssq, sw + l * 4 * 4096, 4096, 1.0f, 1, 0};
          pg8::gemm_phase<pg8::EpiIn, pg8::StaticOrder>(lds3, g, S, E, nullptr); }
        grid.sync();
        if (PH(5)) pool_gate((char*)smem, R0, R1, P.a_scale + l * 2048, bx, G);
        grid.sync();
        if (PH(6)) { pg8::Gemm g{R1, (const bf16_t*)(ws + WT_OUT + l * 4 * MiB), MTOK, 1024, 2048};
          pg8::StaticOrder S; S.init(MTOK, 1024, G, bx);
          pg8::EpiOut E{l == 0 ? P.x : P.out, P.out, mod + l * 4 * 3072 + 2048, 3072, ssq, gs + (l + 1) * 4096, UB, gs + 4 * 4096, l == 1 ? R0 : nullptr};
          pg8::gemm_phase<pg8::EpiOut, pg8::StaticOrder>(lds3, g, S, E, nullptr); }
        grid.sync();
    }
    if (PH(7)) { pg8::Gemm g{R0, (const bf16_t*)(ws + WT_KV), MTOK, 4096, 1024};
      pg8::StaticOrder S; S.init(MTOK, 4096, G, bx);
      pg8::EpiIn E{R1, R2, ssq, sw + 4 * 4 * 4096, 4096, 1.0f, 0, 0};
      pg8::gemm_phase<pg8::EpiIn, pg8::StaticOrder>(lds3, g, S, E, nullptr); }
    grid.sync();
    for (int l = 0; l < 2; ++l) {
        const bf16_t* Wt = (const bf16_t*)(ws + WT_BIN + l * 8 * MiB);
        if (PH(8)) { pg8::Gemm g{UB, Wt, MTOK, 2048, 1024};
          pg8::StaticOrder S; S.init(MTOK, 2048, G, bx);
          pg8::EpiIn E{R0, R0, ssq, sw + (2 + l) * 4 * 4096, 4096, QSCALE, 0, 0};
          pg8::gemm_phase<pg8::EpiIn, pg8::StaticOrder>(lds3, g, S, E, nullptr); }
        grid.sync();
        if (PH(9)) att::attn_phase((char*)smem, R0, R1, R2, P.b_rel_bias + l * 16 * 257, vcu, G);
        grid.sync();
        if (PH(10)) { pg8::Gemm g{UB, Wt + (size_t)2048 * 1024, MTOK, 2048, 1024};
          pg8::StaticOrder S; S.init(MTOK, 2048, G, bx);
          pg8::EpiIn E{R0, R0, ssq, sw + (2 + l) * 4 * 4096 + 2048, 4096, 1.0f, 1, 1};
          pg8::gemm_phase<pg8::EpiIn, pg8::StaticOrder>(lds3, g, S, E, nullptr); }
        grid.sync();
        if (PH(11)) { pg8::Gemm g{R0, (const bf16_t*)(ws + WT_BOUT + l * 4 * MiB), MTOK, 1024, 2048};
          pg8::StaticOrder S; S.init(MTOK, 1024, G, bx);
          pg8::EpiOut E{P.out, P.out, mod + (2 + l) * 4 * 3072 + 2048, 3072, ssq, gs + 3 * 4096, l == 0 ? UB : nullptr, gs, nullptr};
          pg8::gemm_phase<pg8::EpiOut, pg8::StaticOrder>(lds3, g, S, E, nullptr); }
        grid.sync();
    }
    if (PH(12)) final_norm(P, bx, G);
}

extern "C" void kernel_launch(void* const* d_in, const int* in_sizes, int n_in, void* d_out, int out_size, void* d_ws, size_t ws_size, hipStream_t stream) {
    static int grid_blocks = 0;
    if (grid_blocks == 0) {
        if (n_in != 17 || in_sizes[0] != MTOK * DM || out_size != MTOK * DM || ws_size < WS_END) {
            fprintf(stderr, "kernel_launch: shape/workspace mismatch: n_in %d in0 %d out %d ws %zu (need %zu)\n", n_in, n_in > 0 ? in_sizes[0] : -1, out_size, ws_size, (size_t)WS_END); grid_blocks = -1; return; }
        int dev = 0, cus = 0, per_cu = 0;
        hipGetDevice(&dev); hipDeviceGetAttribute(&cus, hipDeviceAttributeMultiprocessorCount, dev);
        if (hipFuncSetAttribute((const void*)yoco_fwd, hipFuncAttributeMaxDynamicSharedMemorySize, LDS_BYTES) != hipSuccess) { fprintf(stderr, "kernel_launch: hipFuncSetAttribute failed\n"); grid_blocks = -1; return; }
        if (hipOccupancyMaxActiveBlocksPerMultiprocessor(&per_cu, (const void*)yoco_fwd, 512, LDS_BYTES) != hipSuccess || per_cu < 1) { fprintf(stderr, "kernel_launch: occupancy query gave %d\n", per_cu); per_cu = 1; (void)hipGetLastError(); }
        grid_blocks = cus * 1;
    }
    if (grid_blocks < 0) return;
    (void)hipMemsetAsync((char*)d_ws + WS_MOD, 0, MOD_BYTES, stream);
    Params p{};
    p.x = (const float*)d_in[0]; p.c = (const float*)d_in[1]; p.ada_w = (const float*)d_in[2]; p.ada_b = (const float*)d_in[3]; p.norm_g = (const float*)d_in[4];
    p.a_w_in = (const float*)d_in[5]; p.a_w_group = (const float*)d_in[6]; p.a_scale = (const float*)d_in[7]; p.a_w_out = (const float*)d_in[8];
    p.kv_norm_g = (const float*)d_in[9]; p.kv_ada_w = (const float*)d_in[10]; p.kv_ada_b = (const float*)d_in[11]; p.w_kv = (const float*)d_in[12];
    p.b_w_in = (const float*)d_in[13]; p.b_rel_bias = (const float*)d_in[14]; p.b_w_out = (const float*)d_in[15]; p.final_g = (const float*)d_in[16];
    p.out = (float*)d_out; p.ws = (unsigned char*)d_ws;
    void* args[] = {&p};
    const hipError_t e = hipLaunchCooperativeKernel((const void*)yoco_fwd, dim3(grid_blocks), dim3(512), args, LDS_BYTES, stream);
    if (e != hipSuccess) fprintf(stderr, "kernel_launch: cooperative launch failed: %s (grid %d)\n", hipGetErrorString(e), grid_blocks);
}
```

```cpp
#include <hip/hip_runtime.h>
#include <hip/hip_cooperative_groups.h>
#include <cstdio>
#include <cstdint>
namespace cg = cooperative_groups;
__device__ __forceinline__ int opaque_tid() { int t = threadIdx.x; asm volatile("" : "+v"(t)); return t; }
namespace pg8 {
#define PG8_LAS __attribute__((address_space(3)))
typedef unsigned short bf16_t;
typedef short bf16x8 __attribute__((ext_vector_type(8)));
typedef float f32x4 __attribute__((ext_vector_type(4)));
typedef unsigned u32x4 __attribute__((ext_vector_type(4)));
constexpr int BM = 256, BK = 64, HALF = 128, HTB = HALF * BK * 2  , STAGE_BYTES = 8 * HTB, NXCD = 8, WGM = 8;

__host__ __device__ __forceinline__ int lds_byte(int r, int c) { const int st = (r >> 4) * 2 + (c >> 5), rr = r & 15, cc = c & 31, ob = rr * 64 + cc * 2; return st * 1024 + (ob ^ (((ob >> 9) & 1) << 5)); }
__host__ __device__ __forceinline__ void stage_rc(int b, int& R, int& C) { const int st = b / 1024, sb = b % 1024, swz = sb ^ (((sb >> 9) & 1) << 5); R = (st >> 1) * 16 + swz / 64; C = (st & 1) * 32 + (swz % 64) / 2; }
__host__ __device__ __forceinline__ int perm32(int rho) { const int n = rho >> 4, i = rho & 15; return 8 * (i >> 2) + 4 * n + (i & 3); }

struct Unit { int pm, pn; };
struct Gemm { const bf16_t* A; const bf16_t* Bt; int M, N, K; size_t bstride; int apanel; };

struct StaticOrder {
    int nM, nN, nwg, G, c;
    __host__ __device__ void init(int M, int N, int G_, int c_) { nM = M / BM; nN = N / BM; nwg = nM * nN; G = G_; c = c_; }
    __host__ __device__ bool next(int i, Unit& u) const {
        const long L = (long)i * G + c; if (L >= nwg) return false;
        int wgid = (int)L; { const int q = nwg / NXCD, r = nwg % NXCD, xcd = wgid % NXCD, off = wgid / NXCD; wgid = (xcd < r ? xcd * (q + 1) : r * (q + 1) + (xcd - r) * q) + off; }
        const int nig = WGM * nN, gid = wgid / nig, fm = gid * WGM, gsz = (nM - fm) < WGM ? (nM - fm) : WGM;
        u.pm = fm + ((wgid % nig) % gsz); u.pn = (wgid % nig) / gsz; return true;
    }
    __device__ __forceinline__ void a_ready(const Unit&) const {}
    __device__ __forceinline__ void done(const Unit&) const {}
};
__device__ __forceinline__ unsigned cvt_pk_bf16(float lo, float hi) { unsigned r; asm volatile("v_cvt_pk_bf16_f32 %0, %1, %2" : "=v"(r) : "v"(lo), "v"(hi)); return r; }

__device__ __forceinline__ float silu_f(float v) { return v * __builtin_amdgcn_rcpf(1.0f + __builtin_amdgcn_exp2f(-1.4426950408889634f * v)); }
__device__ __forceinline__ float bf_lo(unsigned w) { return __uint_as_float(w << 16); }
__device__ __forceinline__ float bf_hi(unsigned w) { return __uint_as_float(w & 0xffff0000u); }

struct EpiIn {
    static constexpr bool PERM = true, AFTER_DRAIN = false, WIDE = true;
    bf16_t* O0; bf16_t* O1; const PG8_LAS unsigned char* stg; float scale0; int silu1; int mulin; int hm;
    __device__ __forceinline__ void operator()(const f32x4 (&acc)[2][2][4][2], const Unit& u, int wr, int wc, int fr, int fq, int ui) const {
        const int row0 = u.pm * BM + wr * 64 + fr; const int half = u.pn >= 8;
        bf16_t* base = half ? O1 : O0; const int colt = (u.pn & 7) * BM;
        const int col0 = colt + wc * 64 + 8 * fq, bcol0 = u.pn * BM + wc * 64 + 8 * fq;
        const PG8_LAS unsigned char* slot = stg + ui * 2048;
        f32x4 bv[2][2];
#pragma unroll
        for (int bj = 0; bj < 2; ++bj)
#pragma unroll
            for (int n = 0; n < 2; ++n) bv[bj][n] = *(const PG8_LAS f32x4*)(slot + 1024 + (wc * 64 + 8 * fq + bj * 32 + 4 * n) * 4);
#pragma unroll
        for (int ai = 0; ai < 2; ++ai)
#pragma unroll
            for (int m = 0; m < 4; ++m) {
                const int row = row0 + ai * HALF + m * 16;
                const float rstd = *(const PG8_LAS float*)(slot + (wr * 64 + fr + ai * HALF + m * 16) * 4);
                bf16_t* rowp = hm ? base + ((size_t)((row >> 13) * 16 + (colt >> 7) + (wc >> 1)) * 8192 + (row & 8191)) * 128 + (wc & 1) * 64 + 8 * fq : base + ((size_t)(u.pn & 7) * 32768 + row) * 256 + wc * 64 + 8 * fq;
                const int bjs = 32;
#pragma unroll
                for (int bj = 0; bj < 2; ++bj) {
                    f32x4 v0 = acc[ai][bj][m][0] * rstd + bv[bj][0], v1 = acc[ai][bj][m][1] * rstd + bv[bj][1];
                    if (mulin) {
                        const u32x4 a = *(const u32x4*)(rowp + (size_t)bj * bjs);
#pragma unroll
                        for (int j = 0; j < 4; ++j) { v0[j] = silu_f(v0[j]); v1[j] = silu_f(v1[j]); }
                        v0[0] *= bf_lo(a.x); v0[1] *= bf_hi(a.x); v0[2] *= bf_lo(a.y); v0[3] *= bf_hi(a.y);
                        v1[0] *= bf_lo(a.z); v1[1] *= bf_hi(a.z); v1[2] *= bf_lo(a.w); v1[3] *= bf_hi(a.w);
                    } else if (half) {
                        if (silu1) {
#pragma unroll
                            for (int j = 0; j < 4; ++j) { v0[j] = silu_f(v0[j]); v1[j] = silu_f(v1[j]); }
                        }
                    } else { v0 *= scale0; v1 *= scale0; }
                    u32x4 w; w.x = cvt_pk_bf16(v0[0], v0[1]); w.y = cvt_pk_bf16(v0[2], v0[3]); w.z = cvt_pk_bf16(v1[0], v1[1]); w.w = cvt_pk_bf16(v1[2], v1[3]);
                    *(u32x4*)(rowp + (size_t)bj * bjs) = w;
                }
            }
    }
};

struct EpiFold {
    static constexpr bool PERM = true, AFTER_DRAIN = false, WIDE = false;
    bf16_t* W0; bf16_t* W1;
    __device__ __forceinline__ void operator()(const f32x4 (&acc)[2][2][4][2], const Unit& u, int wr, int wc, int fr, int fq, int ui) const {
        bf16_t* base = (u.pm >> 3) ? W1 : W0;
        const int row0 = (u.pm & 7) * BM + wr * 64 + fr, col0 = (u.pn & 3) * BM + wc * 32 + 8 * fq;
#pragma unroll
        for (int ai = 0; ai < 2; ++ai)
#pragma unroll
            for (int m = 0; m < 4; ++m) {
                bf16_t* rowp = base + (size_t)(row0 + ai * HALF + m * 16) * 1024 + col0;
#pragma unroll
                for (int bj = 0; bj < 2; ++bj) {
                    const f32x4 v0 = acc[ai][bj][m][0], v1 = acc[ai][bj][m][1];
                    u32x4 w; w.x = cvt_pk_bf16(v0[0], v0[1]); w.y = cvt_pk_bf16(v0[2], v0[3]); w.z = cvt_pk_bf16(v1[0], v1[1]); w.w = cvt_pk_bf16(v1[2], v1[3]);
                    *(u32x4*)(rowp + bj * HALF) = w;
                }
            }
    }
};

struct EpiOut {
    static constexpr bool PERM = true, AFTER_DRAIN = false, WIDE = true;
    const float* hin32; bf16_t* h16; const float* gate; int gate_bstride; float* ssq;
    __device__ __forceinline__ void operator()(const f32x4 (&acc)[2][2][4][2], const Unit& u, int wr, int wc, int fr, int fq, int ui) const {
        const int row0 = u.pm * BM + wr * 64 + fr, col0 = u.pn * BM + wc * 64 + 8 * fq, b = u.pm >> 5;
        float ss[8];
#pragma unroll
        for (int i = 0; i < 8; ++i) ss[i] = 0.f;
#pragma unroll
        for (int bj = 0; bj < 2; ++bj) {
            const int c = col0 + bj * 32;
            const f32x4 g0 = *(const f32x4*)(gate + (size_t)b * gate_bstride + c), g1 = *(const f32x4*)(gate + (size_t)b * gate_bstride + c + 4);
#pragma unroll
            for (int ai = 0; ai < 2; ++ai) {
#define EPIOUT_ROW(M_, H0, H1) do { const int row = row0 + ai * HALF + (M_) * 16; const size_t off = ((size_t)u.pn * 32768 + row) * 256 + (c & 255); \
                    const f32x4 y0 = (H0) + g0 * acc[ai][bj][M_][0], y1 = (H1) + g1 * acc[ai][bj][M_][1]; \
                    ss[ai * 4 + (M_)] += ((y0[0] * y0[0] + y0[1] * y0[1]) + (y0[2] * y0[2] + y0[3] * y0[3])) + ((y1[0] * y1[0] + y1[1] * y1[1]) + (y1[2] * y1[2] + y1[3] * y1[3])); \
                    u32x4 w; w.x = cvt_pk_bf16(y0[0], y0[1]); w.y = cvt_pk_bf16(y0[2], y0[3]); w.z = cvt_pk_bf16(y1[0], y1[1]); w.w = cvt_pk_bf16(y1[2], y1[3]); \
                    *(u32x4*)(h16 + off) = w; } while (0)
                if (hin32) {
#pragma unroll
                    for (int mp = 0; mp < 2; ++mp) {
                        const float* x0 = hin32 + (size_t)(row0 + ai * HALF + (2 * mp) * 16) * 1024 + c; const float* x1 = x0 + 16 * 1024;
                        const f32x4 a0 = *(const f32x4*)x0, a1 = *(const f32x4*)(x0 + 4), b0 = *(const f32x4*)x1, b1 = *(const f32x4*)(x1 + 4);
                        EPIOUT_ROW(2 * mp, a0, a1); EPIOUT_ROW(2 * mp + 1, b0, b1);
                        __builtin_amdgcn_sched_barrier(0);
                    }
                } else {
                    u32x4 hv[4];
#pragma unroll
                    for (int m = 0; m < 4; ++m) hv[m] = *(const u32x4*)(h16 + ((size_t)u.pn * 32768 + row0 + ai * HALF + m * 16) * 256 + (c & 255));
#pragma unroll
                    for (int m = 0; m < 4; ++m) {
                        const f32x4 h0 = {bf_lo(hv[m].x), bf_hi(hv[m].x), bf_lo(hv[m].y), bf_hi(hv[m].y)}, h1 = {bf_lo(hv[m].z), bf_hi(hv[m].z), bf_lo(hv[m].w), bf_hi(hv[m].w)};
                        EPIOUT_ROW(m, h0, h1);
                    }
                }
#undef EPIOUT_ROW
                __builtin_amdgcn_sched_barrier(0);
            }
        }
#pragma unroll
        for (int ai = 0; ai < 2; ++ai)
#pragma unroll
            for (int m = 0; m < 4; ++m) {
                float s = ss[ai * 4 + m]; s += __shfl_xor(s, 16); s += __shfl_xor(s, 32);
                if (fq == 0) ssq[(size_t)(row0 + ai * HALF + m * 16) * 16 + u.pn * 4 + wc] = s;
            }
    }
};

struct FoldOrder {
    int G, c;
    __device__ bool next(int i, Unit& u) const { const int L = i * G + c; if (L >= 64) return false; u.pm = L >> 2; u.pn = (u.pm >> 1) * 4 + (L & 3); return true; }
    __device__ __forceinline__ void a_ready(const Unit&) const {}
    __device__ __forceinline__ void done(const Unit&) const {}
};
template <class Epi, class Sched, bool STAMP = false>
__device__ __forceinline__ void gemm_phase(PG8_LAS unsigned char* lds, const Gemm g, const Sched& S, const Epi& E, unsigned long long* stamps) {
    const int tid = opaque_tid(), wid = __builtin_amdgcn_readfirstlane(tid >> 6), lane = tid & 63, wr = wid >> 2, wc = wid & 3, fr = lane & 15, fq = lane >> 4;
    const int K = g.K, nt = K / BK;
    int ts_lo = 0, ts_hi = 0, nts = 0; const unsigned long long rt_entry = STAMP ? (unsigned long long)wall_clock64() : 0ull;
#define PG8_STAMP() do { if (STAMP && wid == 0 && nts < 64) { const unsigned long long _c = (unsigned long long)clock64(); \
        ts_lo = (lane == nts) ? (int)(unsigned)_c : ts_lo; ts_hi = (lane == nts) ? (int)(unsigned)(_c >> 32) : ts_hi; ++nts; } } while (0)
    PG8_STAMP();
    unsigned voffA[2], voffB[2];
#pragma unroll
    for (int i = 0; i < 2; ++i) { int R, C; stage_rc(tid * 16 + i * 8192, R, C); const int Rb = Epi::WIDE ? ((R >> 5) * 64 + perm32(R & 31)) : (Epi::PERM ? ((R & ~31) + perm32(R & 31)) : R);
        voffA[i] = (unsigned)(R * (g.apanel ? 256 : K) + C) * 2u; voffB[i] = (unsigned)(Rb * K + C) * 2u; }
    const size_t kstep = (size_t)(BK * 2);
    const size_t hstep = (size_t)HALF * K * 2;
    const size_t tstep = 2 * hstep;
    const size_t hstepA = g.apanel ? (size_t)HALF * 512 : hstep, tstepA = 2 * hstepA;
    const size_t pstepA = (size_t)32768 * 512;
    const size_t hstepB = Epi::WIDE ? (size_t)32 * K * 2 : hstep;
    const unsigned ldsw = (unsigned)wid * 1024u;
    const int aoff = lds_byte(wr * 64 + fr, fq * 8), boff = lds_byte(wc * 32 + fr, fq * 8);
#define PG8_SA(b, h) (((b) * 2 + (h)) * HTB)
#define PG8_SB(b, h) ((4 + (b) * 2 + (h)) * HTB)
#define PG8_STAGE(bufoff, gbase, voff) do { _Pragma("unroll") for (int _i = 0; _i < 2; ++_i) \
        __builtin_amdgcn_global_load_lds((const unsigned*)((const char*)(gbase) + (voff)[_i]), (PG8_LAS unsigned*)(lds + (bufoff) + ldsw + _i * 8192), 16, 0, 0); } while (0)
#define PG8_LDA(dst, b, h) do { _Pragma("unroll") for (int m = 0; m < 4; ++m) _Pragma("unroll") for (int k = 0; k < 2; ++k) dst[m][k] = *(const PG8_LAS bf16x8*)(lds + PG8_SA(b, h) + aoff + m * 2048 + k * 1024); } while (0)
#define PG8_LDB(dst, b, h) do { _Pragma("unroll") for (int n = 0; n < 2; ++n) _Pragma("unroll") for (int k = 0; k < 2; ++k) dst[n][k] = *(const PG8_LAS bf16x8*)(lds + PG8_SB(b, h) + boff + n * 2048 + k * 1024); } while (0)
#define PG8_MMA(ai, bj, At, Bt) do { __builtin_amdgcn_s_setprio(1); _Pragma("unroll") for (int m = 0; m < 4; ++m) _Pragma("unroll") for (int n = 0; n < 2; ++n) _Pragma("unroll") for (int k = 0; k < 2; ++k) \
        acc[ai][bj][m][n] = __builtin_amdgcn_mfma_f32_16x16x32_bf16(Bt[n][k], At[m][k], acc[ai][bj][m][n], 0, 0, 0); __builtin_amdgcn_s_setprio(0); } while (0)
#define PG8_WAIT_V(n) asm volatile("s_waitcnt vmcnt(" #n ")" ::: "memory")
#define PG8_WAIT_L(n) asm volatile("s_waitcnt lgkmcnt(" #n ")" ::: "memory")
#define PG8_BAR __builtin_amdgcn_s_barrier()
#define PG8_SCHED __builtin_amdgcn_sched_barrier(0)
    Unit cur, nxt; int ui = 0;
    if (!S.next(0, cur)) return;
    f32x4 acc[2][2][4][2];
#pragma unroll
    for (int a = 0; a < 2; ++a)
#pragma unroll
        for (int b = 0; b < 2; ++b)
#pragma unroll
            for (int m = 0; m < 4; ++m)
#pragma unroll
                for (int n = 0; n < 2; ++n) acc[a][b][m][n] = (f32x4){0.f, 0.f, 0.f, 0.f};
    bf16x8 At[4][2], B0[2][2], B1[2][2];
    const char* cA = (const char*)g.A + (size_t)cur.pm * tstepA; const char* cB = (const char*)g.Bt + (size_t)cur.pn * tstep + (size_t)(cur.pm >> 5) * g.bstride;
    S.a_ready(cur);
    PG8_STAGE(PG8_SB(0, 0), cB, voffB); PG8_STAGE(PG8_SA(0, 0), cA, voffA); PG8_STAGE(PG8_SB(0, 1), cB + hstepB, voffB); PG8_STAGE(PG8_SA(0, 1), cA + hstepA, voffA);
    if (wr == 1) PG8_BAR;
    PG8_WAIT_V(4); PG8_BAR;
    PG8_STAGE(PG8_SB(1, 0), cB + kstep, voffB); PG8_STAGE(PG8_SA(1, 0), cA + kstep, voffA); PG8_STAGE(PG8_SB(1, 1), cB + hstepB + kstep, voffB);
    PG8_WAIT_V(6); PG8_BAR;
    PG8_STAMP();
    for (;;) {
        const bool has_next = S.next(ui + 1, nxt);
        const char* nA = has_next ? (const char*)g.A + (size_t)nxt.pm * tstepA : cA; const char* nB = has_next ? (const char*)g.Bt + (size_t)nxt.pn * tstep + (size_t)(nxt.pm >> 5) * g.bstride : cB;
        for (int t = 0; t < nt; t += 2) {
            const bool last = (t == nt - 2);
            const char* a1 = cA + (g.apanel ? (size_t)(t >> 2) * pstepA + (size_t)(t & 3) * kstep : (size_t)t * kstep) + kstep;
            const char* a2 = last ? nA : cA + (g.apanel ? (size_t)((t + 2) >> 2) * pstepA + (size_t)((t + 2) & 3) * kstep : (size_t)(t + 2) * kstep); const char* b2 = last ? nB : cB + (size_t)(t + 2) * kstep;
            const char* a3 = a2 + kstep; const char* b3 = b2 + kstep;
            if (last && has_next) S.a_ready(nxt);
            PG8_LDB(B0, 0, 0); PG8_SCHED; PG8_LDA(At, 0, 0); PG8_STAGE(PG8_SA(1, 1), a1 + hstepA, voffA);
            PG8_WAIT_L(8); PG8_BAR; PG8_WAIT_L(0); PG8_MMA(0, 0, At, B0); PG8_BAR; PG8_SCHED;
            PG8_LDB(B1, 0, 1); PG8_STAGE(PG8_SB(0, 0), b2, voffB);
            PG8_BAR; PG8_WAIT_L(0); PG8_MMA(0, 1, At, B1); PG8_BAR;
            PG8_LDA(At, 0, 1); PG8_STAGE(PG8_SA(0, 0), a2, voffA);
            PG8_BAR; PG8_WAIT_L(0); PG8_MMA(1, 0, At, B0); PG8_BAR; PG8_SCHED;
            PG8_STAGE(PG8_SB(0, 1), b2 + hstepB, voffB);
            PG8_WAIT_V(6); PG8_BAR; PG8_MMA(1, 1, At, B1); PG8_BAR;
            PG8_LDB(B0, 1, 0); PG8_SCHED; PG8_LDA(At, 1, 0); PG8_STAGE(PG8_SA(0, 1), a2 + hstepA, voffA);
            PG8_WAIT_L(8); PG8_BAR; PG8_WAIT_L(0); PG8_MMA(0, 0, At, B0); PG8_BAR; PG8_SCHED;
            PG8_LDB(B1, 1, 1); PG8_STAGE(PG8_SB(1, 0), b3, voffB);
            PG8_BAR; PG8_WAIT_L(0); PG8_MMA(0, 1, At, B1); PG8_BAR;
            PG8_LDA(At, 1, 1); PG8_STAGE(PG8_SA(1, 0), a3, voffA);
            PG8_BAR; PG8_WAIT_L(0); PG8_MMA(1, 0, At, B0); PG8_BAR; PG8_SCHED;
            PG8_STAGE(PG8_SB(1, 1), b3 + hstepB, voffB);
            PG8_WAIT_V(6); PG8_BAR; PG8_MMA(1, 1, At, B1); PG8_BAR;
        }
        PG8_STAMP();
        if constexpr (!Epi::AFTER_DRAIN) { E(acc, cur, wr, wc, fr, fq, ui); S.done(cur); }
        PG8_STAMP();
        if (!has_next) break;
#pragma unroll
        for (int a = 0; a < 2; ++a)
#pragma unroll
            for (int b = 0; b < 2; ++b)
#pragma unroll
                for (int m = 0; m < 4; ++m)
#pragma unroll
                    for (int n = 0; n < 2; ++n) acc[a][b][m][n] = (f32x4){0.f, 0.f, 0.f, 0.f};
        cur = nxt; cA = nA; cB = nB; ++ui;
    }
    PG8_WAIT_V(0);
    if (wr == 0) PG8_BAR;
    PG8_BAR;
    if constexpr (Epi::AFTER_DRAIN) { E.fused(acc, cur, wr, wc, fr, fq, lds, wid, lane); S.done(cur); }
    PG8_STAMP();
    if (STAMP && wid == 0) { stamps[lane] = lane < nts ? (((unsigned long long)(unsigned)ts_hi << 32) | (unsigned)ts_lo) : 0ull;
        if (lane == 62) stamps[62] = rt_entry; if (lane == 63) stamps[63] = (unsigned long long)wall_clock64(); }
#undef PG8_STAMP
#undef PG8_SA
#undef PG8_SB
#undef PG8_STAGE
#undef PG8_LDA
#undef PG8_LDB
#undef PG8_MMA
#undef PG8_WAIT_V
#undef PG8_WAIT_L
#undef PG8_BAR
#undef PG8_SCHED
}
}

typedef unsigned short bf16_t;
typedef short bf16x8 __attribute__((ext_vector_type(8)));
typedef short s16x4 __attribute__((ext_vector_type(4)));
typedef float f32x4 __attribute__((ext_vector_type(4)));
typedef float f32x16 __attribute__((ext_vector_type(16)));
typedef unsigned u32x4 __attribute__((ext_vector_type(4)));
constexpr int MTOK = 32768, DM = 1024, EI = 2048, SEQ = 8192, NB = 4, NH = 16;
constexpr float LOG2E = 1.4426950408889634f;
constexpr float QSCALE = 0.088388347648318440f * LOG2E;
constexpr int STG_OFF = 131072 + 64, STG_SLOTS = 12;
constexpr int LDS_BYTES = STG_OFF + STG_SLOTS * 2048;
#ifndef PHMASK
#define PHMASK 0xffff
#endif
#define PH(b) ((PHMASK >> (b)) & 1)
#ifndef REP_G1
#define REP_G1 1
#endif
#ifndef REP_PG
#define REP_PG 1
#endif
#ifndef REP_G2
#define REP_G2 1
#endif
#ifndef REP_KV
#define REP_KV 1
#endif
#ifndef REP_Q
#define REP_Q 1
#endif
#ifndef REP_AT
#define REP_AT 1
#endif
#ifndef REP_P0W
#define REP_P0W 1
#endif
#ifndef REP_PRO
#define REP_PRO 1
#endif
#ifndef STAG_TICKS
#define STAG_TICKS 0
#endif
#ifndef KVQ_BAR
#define KVQ_BAR 0
#endif
#ifndef REP_SYNC
#define REP_SYNC 0
#endif
constexpr size_t MiB = 1024 * 1024;
constexpr size_t WS_R0 = 0;
constexpr size_t WS_R1 = 128 * MiB;
constexpr size_t WS_R2 = 256 * MiB;
constexpr size_t WS_H = 384 * MiB;
constexpr size_t WT_OUT = 448 * MiB, WT_BOUT = WT_OUT + 2 * 4 * MiB;
constexpr size_t WS_WTB0 = WT_BOUT + 2 * 4 * MiB;
constexpr size_t WS_SSQ = WS_WTB0 + 32 * MiB;
constexpr size_t WS_MOD = WS_SSQ + 2 * MiB;
constexpr size_t MOD_BYTES = (4 * 4 * 3072 + 4 * 2048) * 4;
constexpr size_t WS_BAR = WS_MOD + MOD_BYTES;
constexpr size_t ZERO_BYTES = 256 * 1024;
constexpr size_t WS_GS = WS_MOD + 256 * 1024;
constexpr size_t WS_SW = WS_GS + 128 * 1024;
constexpr size_t WS_END = WS_SW + 512 * 1024;
constexpr size_t WS_WGT = WS_R2;
constexpr size_t WS_BFOLD = WS_R2 + 4 * MiB;
constexpr size_t WT_IN = WS_R1, WT_KV = WT_IN + 2 * 8 * MiB, WT_BIN = WT_KV + 8 * MiB;
static_assert(WS_END <= 512 * MiB, "workspace");

struct Params {
    const float* x; const float* c; const float* ada_w; const float* ada_b; const float* norm_g; const float* a_w_in; const float* a_w_group; const float* a_scale; const float* a_w_out;
    const float* kv_norm_g; const float* kv_ada_w; const float* kv_ada_b; const float* w_kv; const float* b_w_in; const float* b_rel_bias; const float* b_w_out; const float* final_g;
    float* out; unsigned char* ws;
};

#if defined(__HIP_DEVICE_COMPILE__)
__device__ __forceinline__ Params kparams() {
    typedef const float* __attribute__((address_space(4))) * KArgs;
    KArgs p = (KArgs)__builtin_amdgcn_kernarg_segment_ptr(); asm volatile("" : "+s"(p));
    Params r; r.x = p[0]; r.c = p[1]; r.ada_w = p[2]; r.ada_b = p[3]; r.norm_g = p[4]; r.a_w_in = p[5]; r.a_w_group = p[6]; r.a_scale = p[7]; r.a_w_out = p[8];
    r.kv_norm_g = p[9]; r.kv_ada_w = p[10]; r.kv_ada_b = p[11]; r.w_kv = p[12]; r.b_w_in = p[13]; r.b_rel_bias = p[14]; r.b_w_out = p[15]; r.final_g = p[16];
    r.out = (float*)p[17]; r.ws = (unsigned char*)p[18]; return r; }
#else
__device__ __forceinline__ Params kparams() { return Params{}; }
#endif
#define PHASE_BEGIN const Params P = kparams(); unsigned char* ws = P.ws; (void)ws; int G = gridDim.x, bx = blockIdx.x; asm volatile("" : "+s"(G), "+s"(bx)); const int vcu = (G % 8 == 0) ? (bx % 8) * (G / 8) + bx / 8 : bx; (void)vcu; \
    float* ssq = (float*)(ws + WS_SSQ); const float* mod = (const float*)(ws + WS_MOD); const float* gs = (const float*)(ws + WS_GS); const float* sw = (const float*)(ws + WS_SW); \
    bf16_t* R0 = (bf16_t*)(ws + WS_R0); bf16_t* R1 = (bf16_t*)(ws + WS_R1); bf16_t* R2 = (bf16_t*)(ws + WS_R2); bf16_t* H16 = (bf16_t*)(ws + WS_H); \
    (void)ssq; (void)mod; (void)gs; (void)sw; (void)R0; (void)R1; (void)R2; (void)H16;
__device__ __forceinline__ unsigned cvtpk(float lo, float hi) { unsigned r; asm volatile("v_cvt_pk_bf16_f32 %0, %1, %2" : "=v"(r) : "v"(lo), "v"(hi)); return r; }
__device__ __forceinline__ float bflo(unsigned w) { return __uint_as_float(w << 16); }
__device__ __forceinline__ float bfhi(unsigned w) { return __uint_as_float(w & 0xffff0000u); }
__device__ __forceinline__ float wave_sum(float v) {
#pragma unroll
    for (int o = 32; o >= 1; o >>= 1) v += __shfl_xor(v, o);
    return v;
}

namespace att {
#define KSWZ(row, colB) ((row) * 256 + ((colB) ^ (((row) & 7) << 4)))
#define SBAR() __builtin_amdgcn_sched_barrier(0)
__device__ __forceinline__ int crow(int r, int hi) { return (r & 3) + 8 * (r >> 2) + 4 * hi; }
__device__ __forceinline__ void qkt(f32x16& p0, f32x16& p1, const char* Ks, const bf16x8* qr, int r32, int hi) {
    p0 = f32x16{}; p1 = f32x16{};
#pragma unroll
    for (int d0 = 0; d0 < 8; ++d0) { const int cb = (d0 * 16 + hi * 8) * 2;
        const bf16x8 b0 = *reinterpret_cast<const bf16x8*>(Ks + KSWZ(r32, cb));
        const bf16x8 b1 = *reinterpret_cast<const bf16x8*>(Ks + KSWZ(32 + r32, cb));
        p0 = __builtin_amdgcn_mfma_f32_32x32x16_bf16(b0, qr[d0], p0, 0, 0, 0);
        p1 = __builtin_amdgcn_mfma_f32_32x32x16_bf16(b1, qr[d0], p1, 0, 0, 0); }
}
__device__ __forceinline__ int v_st(int k, int c) { const int kk = (k & ~0xC) | ((k & 4) << 1) | ((k & 8) >> 1); return ((kk >> 3) * 4 + (c >> 5)) * 512 + ((kk & 7) * 32 + (c & 31)) * 2; }
__device__ __forceinline__ int v_rd_base(int lane) { return ((lane & 3) << 3) | (((lane >> 2) & 3) << 6) | (((lane >> 4) & 1) << 5) | (((lane >> 5) & 1) << 8); }
constexpr int v_rd_off(int d0, int ks, int half) { return d0 * 512 + ks * 4096 + half * 2048; }
template <int OFF> __device__ __forceinline__ s16x4 tr_read(int vb) {
    s16x4 r; asm volatile("ds_read_b64_tr_b16 %0, %1 offset:%2" : "=&v"(r) : "v"(vb), "i"(OFF) : "memory"); return r;
}
template <int D0> __device__ __forceinline__ void pv_one(f32x16& od, int vb, bf16x8 pa0, bf16x8 pa1, bf16x8 pa2, bf16x8 pa3) {
    const s16x4 l0 = tr_read<v_rd_off(D0, 0, 0)>(vb), h0 = tr_read<v_rd_off(D0, 0, 1)>(vb), l1 = tr_read<v_rd_off(D0, 1, 0)>(vb), h1 = tr_read<v_rd_off(D0, 1, 1)>(vb);
    const s16x4 l2 = tr_read<v_rd_off(D0, 2, 0)>(vb), h2 = tr_read<v_rd_off(D0, 2, 1)>(vb), l3 = tr_read<v_rd_off(D0, 3, 0)>(vb), h3 = tr_read<v_rd_off(D0, 3, 1)>(vb);
    asm volatile("s_waitcnt lgkmcnt(0)" ::: "memory"); SBAR();
#define PK(L, H) (bf16x8){L[0], L[1], L[2], L[3], H[0], H[1], H[2], H[3]}
    od = __builtin_amdgcn_mfma_f32_32x32x16_bf16(pa0, PK(l0, h0), od, 0, 0, 0);
    od = __builtin_amdgcn_mfma_f32_32x32x16_bf16(pa1, PK(l1, h1), od, 0, 0, 0);
    od = __builtin_amdgcn_mfma_f32_32x32x16_bf16(pa2, PK(l2, h2), od, 0, 0, 0);
    od = __builtin_amdgcn_mfma_f32_32x32x16_bf16(pa3, PK(l3, h3), od, 0, 0, 0);
#undef PK
}
constexpr float THR2 = 11.0f;

__device__ __forceinline__ void partialSM(f32x16& p0, f32x16& p1, float& m_reg, float& alpha, float cb) {
    float pmax = p0[0];
#pragma unroll
    for (int r = 1; r < 16; ++r) pmax = fmaxf(pmax, p0[r]);
#pragma unroll
    for (int r = 0; r < 16; ++r) pmax = fmaxf(pmax, p1[r]);
    { auto rr = __builtin_amdgcn_permlane32_swap(__float_as_uint(pmax), __float_as_uint(pmax), false, false);
      pmax = fmaxf(__uint_as_float(rr[0]), __uint_as_float(rr[1])); }
    pmax += cb;
    float mn;
    if (__all(pmax - m_reg <= THR2)) { mn = m_reg; alpha = 1.f; }
    else { mn = fmaxf(m_reg, pmax); alpha = __builtin_amdgcn_exp2f(m_reg - mn); m_reg = mn; }
    const float mnc = mn - cb;
    p0 = p0 - mnc; p1 = p1 - mnc;
#pragma unroll
    for (int r = 0; r < 16; ++r) p0[r] = __builtin_amdgcn_exp2f(p0[r]);
}
__device__ __forceinline__ void finishSM(f32x16& p0, f32x16& p1, float alpha, float& l_reg, bf16x8& pa0, bf16x8& pa1, bf16x8& pa2, bf16x8& pa3) {
#pragma unroll
    for (int r = 0; r < 16; ++r) p1[r] = __builtin_amdgcn_exp2f(p1[r]);
    const f32x16 s16 = p0 + p1;
    float ps = ((s16[0] + s16[1]) + (s16[2] + s16[3])) + ((s16[4] + s16[5]) + (s16[6] + s16[7])) + (((s16[8] + s16[9]) + (s16[10] + s16[11])) + ((s16[12] + s16[13]) + (s16[14] + s16[15])));
    { auto rr = __builtin_amdgcn_permlane32_swap(__float_as_uint(ps), __float_as_uint(ps), false, false);
      ps = __uint_as_float(rr[0]) + __uint_as_float(rr[1]); }
    l_reg = l_reg * alpha + ps;
#define PK4(P, BASE, OUT) do { unsigned a0 = cvtpk(P[BASE + 0], P[BASE + 1]), a1 = cvtpk(P[BASE + 2], P[BASE + 3]);   \
    unsigned b0 = cvtpk(P[BASE + 4], P[BASE + 5]), b1 = cvtpk(P[BASE + 6], P[BASE + 7]);                              \
    auto r0 = __builtin_amdgcn_permlane32_swap(a0, b0, false, false); auto r1 = __builtin_amdgcn_permlane32_swap(a1, b1, false, false); \
    u32x4 w = {r0[0], r1[0], r0[1], r1[1]}; OUT = *reinterpret_cast<bf16x8*>(&w); } while (0)
    PK4(p0, 0, pa0); PK4(p0, 8, pa1); PK4(p1, 0, pa2); PK4(p1, 8, pa3);
#undef PK4
}
__device__ __forceinline__ void add_bias(f32x16& p0, f32x16& p1, const float* tl) {
    f32x16 t0, t1;
#pragma unroll
    for (int r = 0; r < 16; ++r) { const int c = (r & 3) + 8 * (r >> 2); t0[r] = tl[59 - c]; t1[r] = tl[27 - c]; }
    p0 = p0 + t0; p1 = p1 + t1;
}

__device__ __forceinline__ void attn_phase(char* lds, PG8_LAS unsigned char* l3, bf16_t* Qio, const bf16_t* Kb, const bf16_t* Vb, const float* relb, int vcu, int G, bool store) {
    const int wid = __builtin_amdgcn_readfirstlane(opaque_tid() >> 6);
    float* wsf = (float*)(lds + 98304) + wid * 64; float* li_l = wsf; float* al_l = wsf + 32;
    float* tb = (float*)(lds + 98304 + 2048);
    const int ci = wid >> 1;
    for (int it = vcu; it < 2048; it += G) {
        const int tid = opaque_tid(), lane = tid & 63, r32 = lane & 31, hi = lane >> 5;
        const int vb0 = (int)(uintptr_t)lds + 16384 + v_rd_base(lane);
        const int qrow = (wid & 1) * 32 + r32;
        const int cgp = it & 31, bh = it >> 5, h = bh & 15, b = bh >> 4, c0 = cgp * 4;
        if (tid < 320) tb[tid] = relb[h * 257 + (tid < 256 ? tid : 256)] * LOG2E;
        bf16_t* Qw = Qio + ((size_t)(h >> 1) * MTOK + (b * SEQ + c0 * 64 + wid * 32)) * 256 + (h & 1) * 128;
        const bf16_t* Kh = Kb + (size_t)(b * NH + h) * SEQ * 128; const bf16_t* Vh = Vb + (size_t)(b * NH + h) * SEQ * 128;
        int kof[2], vof[2];
#pragma unroll
        for (int i = 0; i < 2; ++i) { const int Pb = wid * 1024 + lane * 16 + i * 8192;
            { const int row = Pb >> 8, cB = (Pb & 255) ^ ((row & 7) << 4); kof[i] = row * 128 + (cB >> 1); }
            { const int sub = Pb >> 9, within = Pb & 511, kk = (sub >> 2) * 8 + (within >> 6), c = (sub & 3) * 32 + ((within & 63) >> 1);
              const int k = (kk & ~0xC) | ((kk & 4) << 1) | ((kk & 8) >> 1); vof[i] = k * 128 + c; } }
        bf16x8 qr[8];
#pragma unroll
        for (int d0 = 0; d0 < 8; ++d0) qr[d0] = *(const bf16x8*)(Qw + (size_t)r32 * 256 + hi * 8 + d0 * 16);
        float m_reg = -1e30f, l_reg = 0.f; f32x16 o[4] = {};
#define GLOAD(k0, slot) do { const bf16_t* kt_ = Kh + (size_t)(k0) * 128; const bf16_t* vt_ = Vh + (size_t)(k0) * 128; _Pragma("unroll") for (int i_ = 0; i_ < 2; ++i_) { \
        __builtin_amdgcn_global_load_lds((const unsigned*)(kt_ + kof[i_]), (PG8_LAS unsigned*)(l3 + (slot) + wid * 1024 + i_ * 8192), 16, 0, 0); \
        __builtin_amdgcn_global_load_lds((const unsigned*)(vt_ + vof[i_]), (PG8_LAS unsigned*)(l3 + (slot) + 16384 + wid * 1024 + i_ * 8192), 16, 0, 0); } } while (0)
#define RESC(a) do { if (__any((a) < 1.f)) { if (hi == 0) al_l[r32] = (a); asm volatile("s_waitcnt lgkmcnt(0)" ::: "memory"); \
        _Pragma("unroll") for (int r = 0; r < 16; ++r) { const float a_ = al_l[crow(r, hi)]; _Pragma("unroll") for (int d = 0; d < 4; ++d) o[d][r] *= a_; } } } while (0)
        const int jstart = (8 - c0) > 0 ? (8 - c0) : 0;
        const int lo = ci > jstart ? ci : jstart, hiw = ci + 8;
        const int hlo = (ci & 2) > jstart ? (ci & 2) : jstart, hhi = (ci & 2) + 10;
        int sc = 0, sp = 65536, sn = 32768;
        GLOAD((c0 - 8 + jstart) * 64, 0); asm volatile("s_waitcnt vmcnt(0)" ::: "memory");
        __syncthreads();
        const float tbclip = tb[256];
        f32x16 pA0 = {}, pA1, pB0 = {}, pB1; float alA = 1.f, alB = 1.f;
#pragma unroll
        for (int r = 0; r < 16; ++r) { pA1[r] = -3e30f; pB1[r] = -3e30f; }
#define ATT_PV() do { const int vb = vb0 + sp; pv_one<0>(o[0], vb, pa0, pa1, pa2, pa3); pv_one<1>(o[1], vb, pa0, pa1, pa2, pa3); pv_one<2>(o[2], vb, pa0, pa1, pa2, pa3); pv_one<3>(o[3], vb, pa0, pa1, pa2, pa3); } while (0)
#define ATT_STEP(PC0, PC1, ALC, PP0, PP1, ALP) do { \
        SBAR(); \
        { const int jn = (j + 1 < 12) ? j + 1 : 11; GLOAD((c0 - 8 + jn) * 64, sn); }        \
        SBAR(); \
        if (j >= hlo && j <= hhi) {        \
            bf16x8 pa0, pa1, pa2, pa3; \
            const int dc = (j >= lo && j <= hiw) ? ci + 8 - j : -1; \
            const float cb = dc < 0 ? -3e30f : (dc >= 3 ? tbclip : 0.f); \
            qkt(PC0, PC1, lds + sc, qr, r32, hi); finishSM(PP0, PP1, ALP, l_reg, pa0, pa1, pa2, pa3); \
            SBAR(); \
            ATT_PV(); \
            if (dc >= 0 && dc <= 2) add_bias(PC0, PC1, tb + (64 * dc + 128 + qrow - 4 * hi - 59)); \
            partialSM(PC0, PC1, m_reg, ALC, cb); RESC(ALC); \
        } else ALC = 1.f; \
        asm volatile("s_waitcnt vmcnt(0)" ::: "memory"); \
        __syncthreads(); \
        { const int t_ = sp; sp = sc; sc = sn; sn = t_; } \
    } while (0)
        { const int j = jstart; ATT_STEP(pB0, pB1, alB, pA0, pA1, alA); }
        for (int j = jstart + 1; j < 13; ++j) {
            ATT_STEP(pA0, pA1, alA, pB0, pB1, alB); ++j;
            ATT_STEP(pB0, pB1, alB, pA0, pA1, alA);
        }
#undef ATT_STEP
#undef ATT_PV
#undef GLOAD
#undef RESC
        if (hi == 0) li_l[r32] = l_reg; asm volatile("s_waitcnt lgkmcnt(0)" ::: "memory");
        { const int le = opaque_tid() & 63, er32 = le & 31, ehi = le >> 5; const bool ev = (le & 1) == 0;
          bf16_t* Qe = store ? Qw + (er32 & ~1) + (size_t)(4 * ehi + (ev ? 0 : 1)) * 256 : nullptr;
          if (Qe) {
#pragma unroll
          for (int r = 0; r < 16; r += 2) {
            const float rl0 = __builtin_amdgcn_rcpf(li_l[crow(r, ehi)]), rl1 = __builtin_amdgcn_rcpf(li_l[crow(r + 1, ehi)]);
#pragma unroll
            for (int d0 = 0; d0 < 4; ++d0) {
                const float x0 = o[d0][r] * rl0, x1 = o[d0][r + 1] * rl1;
                const float snd = ev ? x1 : x0, keep = ev ? x0 : x1;
                const float got = __int_as_float(__builtin_amdgcn_mov_dpp(__float_as_int(snd), 0xB1, 0xF, 0xF, true));
                const unsigned w = ev ? cvtpk(keep, got) : cvtpk(got, keep);
                *(unsigned*)(Qe + (size_t)((r & 3) + 8 * (r >> 2)) * 256 + d0 * 32) = w;
            }
          } }
        }
    }
}
}

__device__ __forceinline__ void p0_mod(const Params& P, char* lds, int bx) {
    float* cact = (float*)lds;
    float* part = (float*)(lds + 16384);
    const int tid = opaque_tid();
    if (bx >= 224) return;
    for (int i = tid; i < 4096; i += 512) { const float v = P.c[i]; cact[i] = v * __builtin_amdgcn_rcpf(1.0f + __builtin_amdgcn_exp2f(-LOG2E * v)); }
    __syncthreads();
    const float* W; const float* bias; float* outp; int pitch, j0;
    float* mod = (float*)(P.ws + WS_MOD);
    if (bx < 192) { const int l = bx / 48; j0 = (bx % 48) * 64; W = P.ada_w + (size_t)l * 1024 * 3072; pitch = 3072; bias = P.ada_b + l * 3072; outp = mod + l * 4 * 3072; }
    else { j0 = (bx - 192) * 64; W = P.kv_ada_w; pitch = 2048; bias = P.kv_ada_b; outp = mod + 4 * 4 * 3072; }
    const int jl = tid & 63, kq = tid >> 6, j = j0 + jl; float a0 = 0.f, a1 = 0.f, a2 = 0.f, a3 = 0.f;
    const float* wp = W + (size_t)(kq * 128) * pitch + j;
#pragma unroll 16
    for (int k = 0; k < 128; ++k) { const float w = wp[(size_t)k * pitch]; const int kk = kq * 128 + k; a0 += cact[kk] * w; a1 += cact[1024 + kk] * w; a2 += cact[2048 + kk] * w; a3 += cact[3072 + kk] * w; }
    part[(kq * 4 + 0) * 64 + jl] = a0; part[(kq * 4 + 1) * 64 + jl] = a1; part[(kq * 4 + 2) * 64 + jl] = a2; part[(kq * 4 + 3) * 64 + jl] = a3;
    __syncthreads();
    if (tid < 256) { const int b = tid >> 6; float s = 0.f;
#pragma unroll
        for (int q = 0; q < 8; ++q) s += part[(q * 4 + b) * 64 + jl];
        outp[b * pitch + j] = s + bias[j]; }
    __syncthreads();
}

__device__ __forceinline__ void transpose_tile(const float* src, int spitch, bf16_t* dst, int dpitch, int r0, int c0, char* lds) {
    bf16_t* tile = (bf16_t*)lds;
    const int tid = opaque_tid();
    { const int rr = tid >> 4, c4 = (tid & 15) * 4;
#pragma unroll
      for (int p = 0; p < 4; ++p) { const int r = p * 32 + rr; const f32x4 v = *(const f32x4*)(src + (size_t)(r0 + r) * spitch + c0 + c4);
          const unsigned w0 = cvtpk(v[0], v[1]), w1 = cvtpk(v[2], v[3]);
          tile[(c4 + 0) * 136 + r] = (bf16_t)(w0 & 0xffffu); tile[(c4 + 1) * 136 + r] = (bf16_t)(w0 >> 16); tile[(c4 + 2) * 136 + r] = (bf16_t)(w1 & 0xffffu); tile[(c4 + 3) * 136 + r] = (bf16_t)(w1 >> 16); } }
    __syncthreads();
    { const int c = tid >> 4, r8 = (tid & 15) * 8;
#pragma unroll
      for (int p = 0; p < 2; ++p) { const int cc = p * 32 + c; const u32x4 w = *(const u32x4*)(tile + cc * 136 + r8); *(u32x4*)(dst + (size_t)(c0 + cc) * dpitch + r0 + r8) = w; } }
    __syncthreads();
}
__device__ __forceinline__ void p0_weights(const Params& P, char* lds, int bx, int G) {
    unsigned char* ws = P.ws;
    for (int t = bx; t < 3328; t += G) {
        const float* src; bf16_t* dst; int spitch, dpitch, ntc, tt;
        if (t < 512) { const int l = t >> 8; tt = t & 255; src = P.a_w_in + (size_t)l * 1024 * 4096 + 2048; spitch = 4096; dst = (bf16_t*)(ws + WT_IN + l * 8 * MiB) + (size_t)2048 * 1024; dpitch = 1024; ntc = 32; }
        else if (t < 1024) { const int l = (t - 512) >> 8; tt = t & 255; src = P.a_w_out + (size_t)l * 2048 * 1024; spitch = 1024; dst = (bf16_t*)(ws + WT_OUT + l * 4 * MiB); dpitch = 2048; ntc = 16; }
        else if (t < 1536) { tt = t - 1024; src = P.w_kv; spitch = 4096; dst = (bf16_t*)(ws + WT_KV); dpitch = 1024; ntc = 64; }
        else if (t < 2560) { const int l = (t - 1536) >> 9; tt = (t - 1536) & 511; src = P.b_w_in + (size_t)l * 1024 * 4096; spitch = 4096; dst = (bf16_t*)(ws + WT_BIN + l * 8 * MiB); dpitch = 1024; ntc = 64; }
        else if (t < 3072) { const int l = (t - 2560) >> 8; tt = t & 255; src = P.b_w_out + (size_t)l * 2048 * 1024; spitch = 1024; dst = (bf16_t*)(ws + WT_BOUT + l * 4 * MiB); dpitch = 2048; ntc = 16; }
        else { const int lg = (t - 3072) >> 5; tt = t & 31; src = P.a_w_group + (size_t)lg * 512 * 512; spitch = 512; dst = (bf16_t*)(ws + WS_WGT) + (size_t)lg * 512 * 512; dpitch = 512; ntc = 8; }
        const int tr = tt / ntc, tc = tt % ntc;
        transpose_tile(src, spitch, dst, dpitch, tr * 128, tc * 64, lds);
    }
    bf16_t* bf = (bf16_t*)(ws + WS_BFOLD);
    for (int i = bx * 512 + opaque_tid(); i < 2 * 4 * 1024 * 64; i += G * 512) {
        const int j8 = i & 63, k = (i >> 6) & 1023, lg = i >> 16, l = lg >> 2, g = lg & 3;
        const float* s = P.a_w_in + ((size_t)l * 1024 + k) * 4096 + g * 512 + j8 * 8;
        const f32x4 v0 = *(const f32x4*)s, v1 = *(const f32x4*)(s + 4);
        u32x4 w; w.x = cvtpk(v0[0], v0[1]); w.y = cvtpk(v0[2], v0[3]); w.z = cvtpk(v1[0], v1[1]); w.w = cvtpk(v1[2], v1[3]);
        *(u32x4*)(bf + (size_t)i * 8) = w;
    }
}

__device__ __forceinline__ void p1_gs(const Params& P) {
    const float* mod = (const float*)(P.ws + WS_MOD); float* gs = (float*)(P.ws + WS_GS);
    for (int i = opaque_tid(); i < 5 * 4096; i += 512) {
        const int idx = i >> 12, b = (i >> 10) & 3, c = i & 1023;
        const float g = idx < 4 ? P.norm_g[idx * 1024 + c] : P.kv_norm_g[c];
        const float sc = idx < 4 ? mod[(idx * 4 + b) * 3072 + 1024 + c] : mod[4 * 4 * 3072 + b * 2048 + 1024 + c];
        gs[i] = g * (1.0f + sc);
    }
}
__device__ __forceinline__ void p1_prep(const Params& P, int bx, int G) {
    float* ssq = (float*)(P.ws + WS_SSQ); bf16_t* h16 = (bf16_t*)(P.ws + WS_H);
    const int tid = opaque_tid(); const int wid = tid >> 6, lane = tid & 63;
    for (int rp = bx * 8 + wid; rp < MTOK / 2; rp += G * 8) {
        f32x4 v[2][4];
#pragma unroll
        for (int q = 0; q < 2; ++q)
#pragma unroll
            for (int k = 0; k < 2; ++k) { const float* xp = P.x + (size_t)(rp * 2 + q) * 1024 + k * 512 + lane * 8; v[q][2 * k] = *(const f32x4*)xp; v[q][2 * k + 1] = *(const f32x4*)(xp + 4); }
#pragma unroll
        for (int q = 0; q < 2; ++q) { const int row = rp * 2 + q; float s = 0.f;
#pragma unroll
            for (int k = 0; k < 2; ++k) { const f32x4 v0 = v[q][2 * k], v1 = v[q][2 * k + 1];
                s += ((v0[0] * v0[0] + v0[1] * v0[1]) + (v0[2] * v0[2] + v0[3] * v0[3])) + ((v1[0] * v1[0] + v1[1] * v1[1]) + (v1[2] * v1[2] + v1[3] * v1[3]));
                u32x4 w; w.x = cvtpk(v0[0], v0[1]); w.y = cvtpk(v0[2], v0[3]); w.z = cvtpk(v1[0], v1[1]); w.w = cvtpk(v1[2], v1[3]);
                *(u32x4*)(h16 + ((size_t)(2 * k + (lane >> 5)) * MTOK + row) * 256 + (lane & 31) * 8) = w; }
            s = wave_sum(s);
            if (lane < 16) ssq[(size_t)row * 16 + lane] = lane == 0 ? s : 0.f; }
    }
}
__device__ __forceinline__ void p2_scale(const Params& P, int bx, int G) {
    const float* gs = (const float*)(P.ws + WS_GS);
    for (int i0 = bx * 512 + opaque_tid(); i0 < 5 * 4096 * 64; i0 += G * 512) {
        u32x4 w[2]; int k8[2], n[2], widx[2];
#pragma unroll
        for (int q = 0; q < 2; ++q) { const int i = i0 + q * (5 * 4096 * 64); k8[q] = i & 127; n[q] = (i >> 7) & 4095; widx[q] = i >> 19;
            const bf16_t* Wt = (const bf16_t*)(P.ws + (widx[q] < 2 ? WT_IN + widx[q] * 8 * MiB : (widx[q] < 4 ? WT_BIN + (widx[q] - 2) * 8 * MiB : WT_KV)));
            w[q] = *(const u32x4*)(Wt + (size_t)n[q] * 1024 + k8[q] * 8); }
#pragma unroll
        for (int q = 0; q < 2; ++q) {
            bf16_t* dst = widx[q] == 0 ? (bf16_t*)(P.ws + WS_WTB0) : (bf16_t*)((unsigned char*)P.out + (size_t)(widx[q] - 1) * 32 * MiB);
            const float wv[8] = {bflo(w[q].x), bfhi(w[q].x), bflo(w[q].y), bfhi(w[q].y), bflo(w[q].z), bfhi(w[q].z), bflo(w[q].w), bfhi(w[q].w)};
#pragma unroll
            for (int b = 0; b < 4; ++b) {
                const f32x4 g0 = *(const f32x4*)(gs + (widx[q] * 4 + b) * 1024 + k8[q] * 8), g1 = *(const f32x4*)(gs + (widx[q] * 4 + b) * 1024 + k8[q] * 8 + 4);
                u32x4 o; o.x = cvtpk(wv[0] * g0[0], wv[1] * g0[1]); o.y = cvtpk(wv[2] * g0[2], wv[3] * g0[3]); o.z = cvtpk(wv[4] * g1[0], wv[5] * g1[1]); o.w = cvtpk(wv[6] * g1[2], wv[7] * g1[3]);
                *(u32x4*)(dst + ((size_t)b * 4096 + n[q]) * 1024 + k8[q] * 8) = o;
            }
        }
    }
}

__device__ __forceinline__ void p2_sw(const Params& P, char* lds, int bx, int G) {
    float* sh = (float*)lds;
    const float* mod = (const float*)(P.ws + WS_MOD); float* sw = (float*)(P.ws + WS_SW);
    const int tid = opaque_tid(), wid = tid >> 6, lane = tid & 63;
    int curw = -1;
    for (int it = bx; it < 5 * 128; it += G) {
        const int widx = it >> 7, n0 = (it & 127) * 32;
        if (widx != curw) { curw = widx; __syncthreads();
            for (int i = tid; i < 4096; i += 512) { const int b = i >> 10, k = i & 1023;
                const int layer = widx < 2 ? widx : (widx < 4 ? widx : -1);
                sh[i] = widx < 4 ? mod[(layer * 4 + b) * 3072 + k] : mod[4 * 4 * 3072 + b * 2048 + k]; }
            __syncthreads(); }
        const bf16_t* Wt = (const bf16_t*)(P.ws + (widx < 2 ? WT_IN + widx * 8 * MiB : (widx < 4 ? WT_BIN + (widx - 2) * 8 * MiB : WT_KV)));
#pragma unroll 1
        for (int q = 0; q < 4; ++q) { const int n = n0 + wid * 4 + q;
            const u32x4 w0 = *(const u32x4*)(Wt + (size_t)n * 1024 + lane * 16), w1 = *(const u32x4*)(Wt + (size_t)n * 1024 + lane * 16 + 8);
            float wv[16] = {bflo(w0.x), bfhi(w0.x), bflo(w0.y), bfhi(w0.y), bflo(w0.z), bfhi(w0.z), bflo(w0.w), bfhi(w0.w), bflo(w1.x), bfhi(w1.x), bflo(w1.y), bfhi(w1.y), bflo(w1.z), bfhi(w1.z), bflo(w1.w), bfhi(w1.w)};
            float a[4];
#pragma unroll
            for (int b = 0; b < 4; ++b) { float s = 0.f;
#pragma unroll
                for (int k4 = 0; k4 < 4; ++k4) { const f32x4 sv = *(const f32x4*)(sh + b * 1024 + lane * 16 + k4 * 4); s += sv[0] * wv[k4 * 4] + sv[1] * wv[k4 * 4 + 1] + sv[2] * wv[k4 * 4 + 2] + sv[3] * wv[k4 * 4 + 3]; }
                a[b] = wave_sum(s); }
            if (lane == 0) { sw[(widx * 4 + 0) * 4096 + n] = a[0]; sw[(widx * 4 + 1) * 4096 + n] = a[1]; sw[(widx * 4 + 2) * 4096 + n] = a[2]; sw[(widx * 4 + 3) * 4096 + n] = a[3]; } }
    }
    __syncthreads();
}

__device__ __forceinline__ void pool_gate(char* lds, const bf16_t* vg, const bf16_t* sz, bf16_t* outp, const float* a_scale, int bx, int G) {
    const int tid = opaque_tid(), wid = tid >> 6, lane = tid & 63;
    const int r0 = wid * 8;
    u32x4 st[10], zr[8];
#define PG_FETCH(IT) do { const int g_ = (IT) & 3, m0_ = ((IT) >> 2) * 64, t0_ = m0_ & (SEQ - 1); \
        _Pragma("unroll") for (int k = 0; k < 10; ++k) { const int p = tid + k * 512, lr = p >> 6, c16 = p & 63; u32x4 v = {0u, 0u, 0u, 0u}; \
            if (p < 79 * 64 && (t0_ + lr - 15) >= 0) v = *(const u32x4*)(vg + ((size_t)(2 * g_ + (c16 >> 5)) * MTOK + (m0_ + lr - 15)) * 256 + (c16 & 31) * 8); st[k] = v; } \
        _Pragma("unroll") for (int r = 0; r < 8; ++r) zr[r] = *(const u32x4*)(sz + ((size_t)(2 * g_ + (lane >> 5)) * MTOK + (m0_ + r0 + r)) * 256 + (lane & 31) * 8); } while (0)
    if (bx < 2048) PG_FETCH(bx);
    for (int it = bx; it < 2048; it += G) {
        const int g = it & 3, rt = it >> 2, m0 = rt * 64, t0 = m0 & (SEQ - 1), w = 2 << g;
        __syncthreads();
#pragma unroll
        for (int k = 0; k < 10; ++k) { const int p = tid + k * 512; if (p < 79 * 64) *(u32x4*)(lds + (size_t)p * 16) = st[k]; }
        u32x4 zc[8];
#pragma unroll
        for (int r = 0; r < 8; ++r) zc[r] = zr[r];
        __syncthreads();
        if (it + G < 2048) PG_FETCH(it + G);
        const int e = g * 512 + lane * 8;
        const f32x4 as0 = *(const f32x4*)(a_scale + e), as1 = *(const f32x4*)(a_scale + e + 4);
        float ws8[8];
#pragma unroll
        for (int i = 0; i < 8; ++i) ws8[i] = 0.f;
        for (int k = 1; k < w; ++k) { const u32x4 v = *(const u32x4*)(lds + (size_t)(r0 + 15 - k) * 1024 + lane * 16);
            ws8[0] += bflo(v.x); ws8[1] += bfhi(v.x); ws8[2] += bflo(v.y); ws8[3] += bfhi(v.y); ws8[4] += bflo(v.z); ws8[5] += bfhi(v.z); ws8[6] += bflo(v.w); ws8[7] += bfhi(v.w); }
#pragma unroll
        for (int r = 0; r < 8; ++r) {
            const int lr = r0 + r + 15;
            const u32x4 v = *(const u32x4*)(lds + (size_t)lr * 1024 + lane * 16);
            const float x[8] = {bflo(v.x), bfhi(v.x), bflo(v.y), bfhi(v.y), bflo(v.z), bfhi(v.z), bflo(v.w), bfhi(v.w)};
#pragma unroll
            for (int i = 0; i < 8; ++i) ws8[i] += x[i];
            const int t = t0 + r0 + r; const int cnt = (t + 1) < w ? (t + 1) : w; const float inv = 1.0f / (float)cnt;
            const size_t off = ((size_t)(2 * g + (lane >> 5)) * MTOK + (m0 + r0 + r)) * 256 + (lane & 31) * 8;
            const u32x4 z = zc[r];
            float zz[8] = {bflo(z.x), bfhi(z.x), bflo(z.y), bfhi(z.y), bflo(z.z), bfhi(z.z), bflo(z.w), bfhi(z.w)};
#pragma unroll
            for (int i = 0; i < 8; ++i) zz[i] = zz[i] * __builtin_amdgcn_rcpf(1.0f + __builtin_amdgcn_exp2f(-LOG2E * zz[i]));
            float o[8];
#pragma unroll
            for (int i = 0; i < 8; ++i) o[i] = (ws8[i] * inv - x[i]) * (i < 4 ? as0[i & 3] : as1[i & 3]) * zz[i];
            u32x4 wv; wv.x = cvtpk(o[0], o[1]); wv.y = cvtpk(o[2], o[3]); wv.z = cvtpk(o[4], o[5]); wv.w = cvtpk(o[6], o[7]);
            *(u32x4*)(outp + off) = wv;
            const u32x4 d = *(const u32x4*)(lds + (size_t)(lr - w + 1) * 1024 + lane * 16);
            ws8[0] -= bflo(d.x); ws8[1] -= bfhi(d.x); ws8[2] -= bflo(d.y); ws8[3] -= bfhi(d.y); ws8[4] -= bflo(d.z); ws8[5] -= bfhi(d.z); ws8[6] -= bflo(d.w); ws8[7] -= bfhi(d.w);
        }
    }
#undef PG_FETCH
    __syncthreads();
}

__device__ __forceinline__ void final_norm(const Params& P, int bx, int G) {
    const float* ssq = (const float*)(P.ws + WS_SSQ); const bf16_t* h16 = (const bf16_t*)(P.ws + WS_H);
    const int tid = opaque_tid(); const int wid = tid >> 6, lane = tid & 63;
    f32x4 g[4];
#pragma unroll
    for (int k = 0; k < 2; ++k) { g[2 * k] = *(const f32x4*)(P.final_g + k * 512 + lane * 8); g[2 * k + 1] = *(const f32x4*)(P.final_g + k * 512 + lane * 8 + 4); }
    for (int row = bx * 8 + wid; row < MTOK; row += G * 8) {
        const f32x4* sp = (const f32x4*)(ssq + (size_t)row * 16);
        const f32x4 st = (sp[0] + sp[1]) + (sp[2] + sp[3]);
        const float rstd = __builtin_amdgcn_rsqf(((st[0] + st[1]) + (st[2] + st[3])) * (1.0f / 1024.0f) + 1e-6f);
        float* op = P.out + (size_t)row * 1024;
#pragma unroll
        for (int k = 0; k < 2; ++k) { const int c = k * 512 + lane * 8; const u32x4 hv = *(const u32x4*)(h16 + ((size_t)(2 * k + (lane >> 5)) * MTOK + row) * 256 + (lane & 31) * 8);
            const f32x4 v0 = {bflo(hv.x), bfhi(hv.x), bflo(hv.y), bfhi(hv.y)}, v1 = {bflo(hv.z), bfhi(hv.z), bflo(hv.w), bfhi(hv.w)};
            *(f32x4*)(op + c) = v0 * rstd * g[2 * k]; *(f32x4*)(op + c + 4) = v1 * rstd * g[2 * k + 1]; }
    }
}

#define XB_TMO      128
#define XB_XCNT(j)  (256  + 64 * (j))
#define XB_XSUB(j)  (1280 + 64 * (j))
#define XB_XGEN(j)  (2304 + 64 * (j))
#define XB_TOP      3328
#define XB_TOPGEN   3392
#define XCD_BAR_WORDS 3456
#define XB_SPIN_CAP (1u << 18)
#define LAS __attribute__((address_space(3)))

__device__ __forceinline__ unsigned xb_ld(unsigned* p)              { return __hip_atomic_load(p, __ATOMIC_RELAXED, __HIP_MEMORY_SCOPE_AGENT); }
__device__ __forceinline__ unsigned xb_add(unsigned* p, unsigned v) { return __hip_atomic_fetch_add(p, v, __ATOMIC_RELAXED, __HIP_MEMORY_SCOPE_AGENT); }
__device__ __forceinline__ unsigned xb_xcc_id() { return (unsigned)__builtin_amdgcn_s_getreg((3 << 11) | 20) & 0xFu; }
#define XB_SPIN(cond, bar) do { unsigned _sp = 0; while (cond) { __builtin_amdgcn_s_sleep(1); \
    if ((++_sp & 255u) == 0u) { if (xb_ld(&(bar)[XB_TMO])) break; if (_sp > XB_SPIN_CAP) { atomicAdd(&(bar)[XB_TMO], 1u); break; } } } } while (0)

struct XcdBarrier {
    unsigned* bar; unsigned x;
    volatile LAS unsigned* st;
};

__device__ __forceinline__ XcdBarrier xcd_barrier_post(unsigned* bar, volatile LAS unsigned* st) {
    XcdBarrier b; b.bar = bar; b.x = xb_xcc_id(); b.st = st;
    if (threadIdx.x == 0) (void)xb_add(&bar[XB_XCNT(b.x)], 1u);
    return b;
}
__device__ __forceinline__ void xcd_barrier_complete(unsigned* bar, unsigned x, unsigned& nloc, unsigned& nx) {
    const unsigned G = gridDim.x * gridDim.y * gridDim.z;
    unsigned sum, cnt, mine, sp = 0u;
    for (;;) {
        sum = 0u; cnt = 0u; mine = 0u;
#pragma unroll
        for (unsigned j = 0; j < 16; ++j) { const unsigned c = xb_ld(&bar[XB_XCNT(j)]); sum += c; cnt += (c > 0u) ? 1u : 0u; mine = (j == x) ? c : mine; }
        if (sum == G) break;
        __builtin_amdgcn_s_sleep(1);
        if ((++sp & 255u) == 0u) { if (xb_ld(&bar[XB_TMO])) break; if (sp > XB_SPIN_CAP) { atomicAdd(&bar[XB_TMO], 1u); break; } }
    }
    nloc = mine > 0u ? mine : 1u; nx = cnt > 0u ? cnt : 1u;
}

__device__ __forceinline__ void xcd_barrier(const XcdBarrier& b) {
    asm volatile("s_waitcnt vmcnt(0)" ::: "memory");
    __syncthreads();
    if (threadIdx.x == 0) {
        unsigned* bar = b.bar;
        __builtin_amdgcn_s_waitcnt(0);
        unsigned nloc = b.st[0], nx = b.st[1];
        if (nloc == 0u) { xcd_barrier_complete(bar, b.x, nloc, nx); b.st[0] = nloc; b.st[1] = nx; }
        const unsigned old = xb_add(&bar[XB_XSUB(b.x)], 1u);
        const unsigned gen = old / nloc;
        if (old + 1u == (gen + 1u) * nloc) {
            __builtin_amdgcn_fence(__ATOMIC_RELEASE, "agent");
            asm volatile("s_waitcnt vmcnt(0)" ::: "memory");
            const unsigned og = xb_add(&bar[XB_TOP], 1u);
            const unsigned tg = og / nx;
            if (og + 1u == (tg + 1u) * nx) xb_add(&bar[XB_TOPGEN], 1u);
            else XB_SPIN(xb_ld(&bar[XB_TOPGEN]) == tg, bar);
            __builtin_amdgcn_fence(__ATOMIC_ACQUIRE, "agent");
            xb_add(&bar[XB_XGEN(b.x)], 1u);
            asm volatile("s_waitcnt vmcnt(0)" ::: "memory");
        } else {
            XB_SPIN(xb_ld(&bar[XB_XGEN(b.x)]) == gen, bar);
            __builtin_amdgcn_fence(__ATOMIC_ACQUIRE, "agent");
            asm volatile("s_waitcnt vmcnt(0)" ::: "memory");
        }
    }
    __syncthreads();
}


template <class Sched> __device__ __forceinline__ void stage_units(PG8_LAS unsigned char* l3, const Sched& S, const float* ssq, const float* sw, int N) {
    const int tid = opaque_tid();
    pg8::Unit u;
    for (int i = 0; i < STG_SLOTS && S.next(i, u); ++i) {
        PG8_LAS float* slot = (PG8_LAS float*)(l3 + STG_OFF + i * 2048);
        if (tid < 256) { const f32x4* sp = (const f32x4*)(ssq + (size_t)(u.pm * 256 + tid) * 16); const f32x4 st = (sp[0] + sp[1]) + (sp[2] + sp[3]);
            slot[tid] = __builtin_amdgcn_rsqf(((st[0] + st[1]) + (st[2] + st[3])) * (1.0f / 1024.0f) + 1e-6f); }
        else slot[tid] = sw[(size_t)(u.pm >> 5) * N + u.pn * 256 + (tid - 256)];
    }
    __syncthreads();
}
__device__ __forceinline__ void stagger(int bx, int ticks) {
    if (ticks > 0 && ((bx >> 3) & 1)) { const unsigned long long t0 = __builtin_amdgcn_s_memrealtime(); while (__builtin_amdgcn_s_memrealtime() - t0 < (unsigned long long)ticks) __builtin_amdgcn_s_sleep(32); }
}
__global__ void __launch_bounds__(512) yoco_fwd(Params Pin) {
    extern __shared__ __attribute__((aligned(16))) unsigned char smem[];
    cg::grid_group grid = cg::this_grid();
    PG8_LAS unsigned char* lds3 = (PG8_LAS unsigned char*)smem;
    if (threadIdx.x < 4) ((volatile LAS unsigned*)(lds3 + 131072))[threadIdx.x] = 0u;
    __syncthreads();
    { const Params P0_ = kparams(); (void)xcd_barrier_post((unsigned*)(P0_.ws + WS_BAR), (volatile LAS unsigned*)(lds3 + 131072)); }
#define GRID_BAR() do { const Params Pb_ = kparams(); XcdBarrier xb_; xb_.bar = (unsigned*)(Pb_.ws + WS_BAR); xb_.x = xb_xcc_id(); xb_.st = (volatile LAS unsigned*)(lds3 + 131072); xcd_barrier(xb_); } while (0)

    for (int rpro = 0; rpro < REP_PRO; ++rpro) {
    { PHASE_BEGIN
      p0_mod(P, (char*)smem, bx);
      for (int rep = 0; rep < REP_P0W; ++rep) p0_weights(P, (char*)smem, bx, G); }
    for (int rep = 0; rep < REP_SYNC; ++rep) GRID_BAR();
    GRID_BAR();
    { const Params Pq_ = kparams(); if (Pq_.ws == nullptr) grid.sync(); }
    { PHASE_BEGIN
      { pg8::Gemm g{(const bf16_t*)(ws + WS_WGT), (const bf16_t*)(ws + WS_BFOLD), 4096, 8192, 512, 0, 0};
        pg8::FoldOrder S{G, bx}; pg8::EpiFold E{(bf16_t*)(ws + WT_IN), (bf16_t*)(ws + WT_IN + 8 * MiB)};
        pg8::gemm_phase<pg8::EpiFold, pg8::FoldOrder>(lds3, g, S, E, nullptr); }
      if (bx == G - 1) p1_gs(P);
      p1_prep(P, bx, G); }
    GRID_BAR();
    { PHASE_BEGIN
      p2_sw(P, (char*)smem, bx, G);
      p2_scale(P, bx, G); }
    GRID_BAR();

    }
    for (int l = 0; l < 2; ++l) {
        for (int rep = 0; rep < (l == 0 ? REP_G1 : 1); ++rep) { PHASE_BEGIN
          stagger(bx, STAG_TICKS);
          pg8::Gemm g{H16, l == 0 ? (const bf16_t*)(ws + WS_WTB0) : (const bf16_t*)P.out, MTOK, 4096, 1024, 8 * MiB, 1};
          pg8::StaticOrder S; S.init(MTOK, 4096, G, bx);
          stage_units(lds3, S, ssq, sw + l * 4 * 4096, 4096);
          pg8::EpiIn E{R0, R1, lds3 + STG_OFF, 1.0f, 0, 0, 0};
          pg8::gemm_phase<pg8::EpiIn, pg8::StaticOrder>(lds3, g, S, E, nullptr); }
        GRID_BAR();
        for (int rep = 0; rep < REP_PG; ++rep) { PHASE_BEGIN
          pool_gate((char*)smem, R0, R1, rep == REP_PG - 1 ? R1 : R2, P.a_scale + l * 2048, bx, G); }
        GRID_BAR();
        for (int rep = 0; rep < (l == 0 ? REP_G2 : 1); ++rep) { PHASE_BEGIN
          pg8::Gemm g{R1, (const bf16_t*)(ws + WT_OUT + l * 4 * MiB), MTOK, 1024, 2048, 0, 1};
          pg8::StaticOrder S; S.init(MTOK, 1024, G, bx);
          pg8::EpiOut E{l == 0 ? P.x : nullptr, H16, mod + l * 4 * 3072 + 2048, 3072, ssq};
          pg8::gemm_phase<pg8::EpiOut, pg8::StaticOrder>(lds3, g, S, E, nullptr); }
        GRID_BAR();
    }
    for (int l = 0; l < 2; ++l) {
        if (l == 0) for (int rep = 0; rep < REP_KV; ++rep) { PHASE_BEGIN
          stagger(bx, STAG_TICKS);
          pg8::Gemm g{H16, (const bf16_t*)((const unsigned char*)P.out + 3 * 32 * MiB), MTOK, 4096, 1024, 8 * MiB, 1};
          pg8::StaticOrder S; S.init(MTOK, 4096, G, bx);
          stage_units(lds3, S, ssq, sw + 4 * 4 * 4096, 4096);
          pg8::EpiIn E{R1, R2, lds3 + STG_OFF, 1.0f, 0, 0, 1};
          pg8::gemm_phase<pg8::EpiIn, pg8::StaticOrder>(lds3, g, S, E, nullptr); }
        if (l == 0 && KVQ_BAR) GRID_BAR();
        for (int rep = 0; rep < (l == 0 ? REP_Q : 1); ++rep) { PHASE_BEGIN
          pg8::Gemm g{H16, (const bf16_t*)((const unsigned char*)P.out + (size_t)(1 + l) * 32 * MiB), MTOK, 2048, 1024, 8 * MiB, 1};
          pg8::StaticOrder S; S.init(MTOK, 2048, G, bx);
          stage_units(lds3, S, ssq, sw + (2 + l) * 4 * 4096, 4096);
          pg8::EpiIn E{R0, R0, lds3 + STG_OFF, QSCALE, 0, 0, 0};
          pg8::gemm_phase<pg8::EpiIn, pg8::StaticOrder>(lds3, g, S, E, nullptr); }
        GRID_BAR();
        for (int rep = 0; rep < REP_AT; ++rep) { PHASE_BEGIN
          att::attn_phase((char*)smem, lds3, R0, R1, R2, P.b_rel_bias + l * 16 * 257, vcu, G, rep == REP_AT - 1 || P.ws == nullptr); }
        GRID_BAR();
        { PHASE_BEGIN
          stagger(bx, STAG_TICKS);
          pg8::Gemm g{H16, (const bf16_t*)((const unsigned char*)P.out + (size_t)(1 + l) * 32 * MiB) + (size_t)2048 * 1024, MTOK, 2048, 1024, 8 * MiB, 1};
          pg8::StaticOrder S; S.init(MTOK, 2048, G, bx);
          stage_units(lds3, S, ssq, sw + (2 + l) * 4 * 4096 + 2048, 4096);
          pg8::EpiIn E{R0, R0, lds3 + STG_OFF, 1.0f, 1, 1, 0};
          pg8::gemm_phase<pg8::EpiIn, pg8::StaticOrder>(lds3, g, S, E, nullptr); }
        GRID_BAR();
        { PHASE_BEGIN
          pg8::Gemm g{R0, (const bf16_t*)(ws + WT_BOUT + l * 4 * MiB), MTOK, 1024, 2048, 0, 1};
          pg8::StaticOrder S; S.init(MTOK, 1024, G, bx);
          pg8::EpiOut E{nullptr, H16, mod + (2 + l) * 4 * 3072 + 2048, 3072, ssq};
          pg8::gemm_phase<pg8::EpiOut, pg8::StaticOrder>(lds3, g, S, E, nullptr); }
        GRID_BAR();
    }
    { PHASE_BEGIN
      final_norm(P, bx, G); }
}

extern "C" void kernel_launch(void* const* d_in, const int* in_sizes, int n_in, void* d_out, int out_size, void* d_ws, size_t ws_size, hipStream_t stream) {
    static int grid_blocks = 0;
    if (grid_blocks == 0) {
        if (n_in != 17 || in_sizes[0] != MTOK * DM || out_size != MTOK * DM || ws_size < WS_END) {
            fprintf(stderr, "kernel_launch: shape/workspace mismatch: n_in %d in0 %d out %d ws %zu (need %zu)\n", n_in, n_in > 0 ? in_sizes[0] : -1, out_size, ws_size, (size_t)WS_END); grid_blocks = -1; return; }
        int dev = 0, cus = 0, per_cu = 0;
        hipGetDevice(&dev); hipDeviceGetAttribute(&cus, hipDeviceAttributeMultiprocessorCount, dev);
        if (hipFuncSetAttribute((const void*)yoco_fwd, hipFuncAttributeMaxDynamicSharedMemorySize, LDS_BYTES) != hipSuccess) { fprintf(stderr, "kernel_launch: hipFuncSetAttribute failed\n"); grid_blocks = -1; return; }
        if (hipOccupancyMaxActiveBlocksPerMultiprocessor(&per_cu, (const void*)yoco_fwd, 512, LDS_BYTES) != hipSuccess || per_cu < 1) { fprintf(stderr, "kernel_launch: occupancy query gave %d\n", per_cu); per_cu = 1; (void)hipGetLastError(); }
        grid_blocks = cus * 1;
    }
    if (grid_blocks < 0) return;
    (void)hipMemsetAsync((char*)d_ws + WS_BAR, 0, 16 * 1024, stream);
    Params p{};
    p.x = (const float*)d_in[0]; p.c = (const float*)d_in[1]; p.ada_w = (const float*)d_in[2]; p.ada_b = (const float*)d_in[3]; p.norm_g = (const float*)d_in[4];
    p.a_w_in = (const float*)d_in[5]; p.a_w_group = (const float*)d_in[6]; p.a_scale = (const float*)d_in[7]; p.a_w_out = (const float*)d_in[8];
    p.kv_norm_g = (const float*)d_in[9]; p.kv_ada_w = (const float*)d_in[10]; p.kv_ada_b = (const float*)d_in[11]; p.w_kv = (const float*)d_in[12];
    p.b_w_in = (const float*)d_in[13]; p.b_rel_bias = (const float*)d_in[14]; p.b_w_out = (const float*)d_in[15]; p.final_g = (const float*)d_in[16];
    p.out = (float*)d_out; p.ws = (unsigned char*)d_ws;
    void* args[] = {&p};
    const hipError_t e = hipLaunchCooperativeKernel((const void*)yoco_fwd, dim3(grid_blocks), dim3(512), args, LDS_BYTES, stream);
    if (e != hipSuccess) fprintf(stderr, "kernel_launch: cooperative launch failed: %s (grid %d)\n", hipGetErrorString(e), grid_blocks);
}
```

```cpp
#include <hip/hip_runtime.h>
#include <hip/hip_cooperative_groups.h>
#include <cstdio>
#include <cstdint>
namespace cg = cooperative_groups;
__device__ __forceinline__ int opaque_tid() { int t = threadIdx.x; asm volatile("" : "+v"(t)); return t; }
namespace pg8 {
#define PG8_LAS __attribute__((address_space(3)))
typedef unsigned short bf16_t;
typedef short bf16x8 __attribute__((ext_vector_type(8)));
typedef float f32x4 __attribute__((ext_vector_type(4)));
typedef unsigned u32x4 __attribute__((ext_vector_type(4)));
constexpr int BM = 256, BK = 64, HALF = 128, HTB = HALF * BK * 2  , STAGE_BYTES = 8 * HTB, NXCD = 8, WGM = 8;

__host__ __device__ __forceinline__ int lds_byte(int r, int c) { const int st = (r >> 4) * 2 + (c >> 5), rr = r & 15, cc = c & 31, ob = rr * 64 + cc * 2; return st * 1024 + (ob ^ (((ob >> 9) & 1) << 5)); }
__host__ __device__ __forceinline__ void stage_rc(int b, int& R, int& C) { const int st = b / 1024, sb = b % 1024, swz = sb ^ (((sb >> 9) & 1) << 5); R = (st >> 1) * 16 + swz / 64; C = (st & 1) * 32 + (swz % 64) / 2; }
__host__ __device__ __forceinline__ int perm32(int rho) { const int n = rho >> 4, i = rho & 15; return 8 * (i >> 2) + 4 * n + (i & 3); }

struct Unit { int pm, pn; };
struct Gemm { const bf16_t* A; const bf16_t* Bt; int M, N, K; size_t bstride; int apanel; };

struct StaticOrder {
    int nM, nN, nwg, G, c;
    __host__ __device__ void init(int M, int N, int G_, int c_) { nM = M / BM; nN = N / BM; nwg = nM * nN; G = G_; c = c_; }
    __host__ __device__ bool next(int i, Unit& u) const {
        const long L = (long)i * G + c; if (L >= nwg) return false;
        int wgid = (int)L; { const int q = nwg / NXCD, r = nwg % NXCD, xcd = wgid % NXCD, off = wgid / NXCD; wgid = (xcd < r ? xcd * (q + 1) : r * (q + 1) + (xcd - r) * q) + off; }
        const int nig = WGM * nN, gid = wgid / nig, fm = gid * WGM, gsz = (nM - fm) < WGM ? (nM - fm) : WGM;
        u.pm = fm + ((wgid % nig) % gsz); u.pn = (wgid % nig) / gsz; return true;
    }
    __device__ __forceinline__ void a_ready(const Unit&) const {}
    __device__ __forceinline__ void done(const Unit&) const {}
};
__device__ __forceinline__ unsigned cvt_pk_bf16(float lo, float hi) { unsigned r; asm volatile("v_cvt_pk_bf16_f32 %0, %1, %2" : "=v"(r) : "v"(lo), "v"(hi)); return r; }

__device__ __forceinline__ float silu_f(float v) { return v * __builtin_amdgcn_rcpf(1.0f + __builtin_amdgcn_exp2f(-1.4426950408889634f * v)); }
__device__ __forceinline__ float bf_lo(unsigned w) { return __uint_as_float(w << 16); }
__device__ __forceinline__ float bf_hi(unsigned w) { return __uint_as_float(w & 0xffff0000u); }

struct EpiIn {
    static constexpr bool PERM = true, AFTER_DRAIN = false, WIDE = true;
    bf16_t* O0; bf16_t* O1; const PG8_LAS unsigned char* stg; float scale0; int silu1; int mulin; int hm;
    __device__ __forceinline__ void operator()(const f32x4 (&acc)[2][2][4][2], const Unit& u, int wr, int wc, int fr, int fq, int ui) const {
        const int row0 = u.pm * BM + wr * 64 + fr; const int half = u.pn >= 8;
        bf16_t* base = half ? O1 : O0; const int colt = (u.pn & 7) * BM;
        const int col0 = colt + wc * 64 + 8 * fq, bcol0 = u.pn * BM + wc * 64 + 8 * fq;
        const PG8_LAS unsigned char* slot = stg + ui * 2048;
        f32x4 bv[2][2];
#pragma unroll
        for (int bj = 0; bj < 2; ++bj)
#pragma unroll
            for (int n = 0; n < 2; ++n) bv[bj][n] = *(const PG8_LAS f32x4*)(slot + 1024 + (wc * 64 + 8 * fq + bj * 32 + 4 * n) * 4);
#pragma unroll
        for (int ai = 0; ai < 2; ++ai)
#pragma unroll
            for (int m = 0; m < 4; ++m) {
                const int row = row0 + ai * HALF + m * 16;
                const float rstd = *(const PG8_LAS float*)(slot + (wr * 64 + fr + ai * HALF + m * 16) * 4);
                bf16_t* rowp = hm ? base + ((size_t)((row >> 13) * 16 + (colt >> 7) + (wc >> 1)) * 8192 + (row & 8191)) * 128 + (wc & 1) * 64 + 8 * fq : base + ((size_t)(u.pn & 7) * 32768 + row) * 256 + wc * 64 + 8 * fq;
                const int bjs = 32;
#pragma unroll
                for (int bj = 0; bj < 2; ++bj) {
                    f32x4 v0 = acc[ai][bj][m][0] * rstd + bv[bj][0], v1 = acc[ai][bj][m][1] * rstd + bv[bj][1];
                    if (mulin) {
                        const u32x4 a = *(const u32x4*)(rowp + (size_t)bj * bjs);
#pragma unroll
                        for (int j = 0; j < 4; ++j) { v0[j] = silu_f(v0[j]); v1[j] = silu_f(v1[j]); }
                        v0[0] *= bf_lo(a.x); v0[1] *= bf_hi(a.x); v0[2] *= bf_lo(a.y); v0[3] *= bf_hi(a.y);
                        v1[0] *= bf_lo(a.z); v1[1] *= bf_hi(a.z); v1[2] *= bf_lo(a.w); v1[3] *= bf_hi(a.w);
                    } else if (half) {
                        if (silu1) {
#pragma unroll
                            for (int j = 0; j < 4; ++j) { v0[j] = silu_f(v0[j]); v1[j] = silu_f(v1[j]); }
                        }
                    } else { v0 *= scale0; v1 *= scale0; }
                    u32x4 w; w.x = cvt_pk_bf16(v0[0], v0[1]); w.y = cvt_pk_bf16(v0[2], v0[3]); w.z = cvt_pk_bf16(v1[0], v1[1]); w.w = cvt_pk_bf16(v1[2], v1[3]);
                    *(u32x4*)(rowp + (size_t)bj * bjs) = w;
                }
            }
    }
};

struct EpiFold {
    static constexpr bool PERM = true, AFTER_DRAIN = false, WIDE = false;
    bf16_t* W0; bf16_t* W1;
    __device__ __forceinline__ void operator()(const f32x4 (&acc)[2][2][4][2], const Unit& u, int wr, int wc, int fr, int fq, int ui) const {
        bf16_t* base = (u.pm >> 3) ? W1 : W0;
        const int row0 = (u.pm & 7) * BM + wr * 64 + fr, col0 = (u.pn & 3) * BM + wc * 32 + 8 * fq;
#pragma unroll
        for (int ai = 0; ai < 2; ++ai)
#pragma unroll
            for (int m = 0; m < 4; ++m) {
                bf16_t* rowp = base + (size_t)(row0 + ai * HALF + m * 16) * 1024 + col0;
#pragma unroll
                for (int bj = 0; bj < 2; ++bj) {
                    const f32x4 v0 = acc[ai][bj][m][0], v1 = acc[ai][bj][m][1];
                    u32x4 w; w.x = cvt_pk_bf16(v0[0], v0[1]); w.y = cvt_pk_bf16(v0[2], v0[3]); w.z = cvt_pk_bf16(v1[0], v1[1]); w.w = cvt_pk_bf16(v1[2], v1[3]);
                    *(u32x4*)(rowp + bj * HALF) = w;
                }
            }
    }
};

struct EpiOut {
    static constexpr bool PERM = true, AFTER_DRAIN = false, WIDE = true;
    const float* hin32; bf16_t* h16; const float* gate; int gate_bstride; float* ssq;
    __device__ __forceinline__ void operator()(const f32x4 (&acc)[2][2][4][2], const Unit& u, int wr, int wc, int fr, int fq, int ui) const {
        const int row0 = u.pm * BM + wr * 64 + fr, col0 = u.pn * BM + wc * 64 + 8 * fq, b = u.pm >> 5;
        float ss[8];
#pragma unroll
        for (int i = 0; i < 8; ++i) ss[i] = 0.f;
#pragma unroll
        for (int bj = 0; bj < 2; ++bj) {
            const int c = col0 + bj * 32;
            const f32x4 g0 = *(const f32x4*)(gate + (size_t)b * gate_bstride + c), g1 = *(const f32x4*)(gate + (size_t)b * gate_bstride + c + 4);
#pragma unroll
            for (int ai = 0; ai < 2; ++ai) {
#define EPIOUT_ROW(M_, H0, H1) do { const int row = row0 + ai * HALF + (M_) * 16; const size_t off = ((size_t)u.pn * 32768 + row) * 256 + (c & 255); \
                    const f32x4 y0 = (H0) + g0 * acc[ai][bj][M_][0], y1 = (H1) + g1 * acc[ai][bj][M_][1]; \
                    ss[ai * 4 + (M_)] += ((y0[0] * y0[0] + y0[1] * y0[1]) + (y0[2] * y0[2] + y0[3] * y0[3])) + ((y1[0] * y1[0] + y1[1] * y1[1]) + (y1[2] * y1[2] + y1[3] * y1[3])); \
                    u32x4 w; w.x = cvt_pk_bf16(y0[0], y0[1]); w.y = cvt_pk_bf16(y0[2], y0[3]); w.z = cvt_pk_bf16(y1[0], y1[1]); w.w = cvt_pk_bf16(y1[2], y1[3]); \
                    *(u32x4*)(h16 + off) = w; } while (0)
                if (hin32) {
#pragma unroll
                    for (int mp = 0; mp < 2; ++mp) {
                        const float* x0 = hin32 + (size_t)(row0 + ai * HALF + (2 * mp) * 16) * 1024 + c; const float* x1 = x0 + 16 * 1024;
                        const f32x4 a0 = *(const f32x4*)x0, a1 = *(const f32x4*)(x0 + 4), b0 = *(const f32x4*)x1, b1 = *(const f32x4*)(x1 + 4);
                        EPIOUT_ROW(2 * mp, a0, a1); EPIOUT_ROW(2 * mp + 1, b0, b1);
                        __builtin_amdgcn_sched_barrier(0);
                    }
                } else {
                    u32x4 hv[4];
#pragma unroll
                    for (int m = 0; m < 4; ++m) hv[m] = *(const u32x4*)(h16 + ((size_t)u.pn * 32768 + row0 + ai * HALF + m * 16) * 256 + (c & 255));
#pragma unroll
                    for (int m = 0; m < 4; ++m) {
                        const f32x4 h0 = {bf_lo(hv[m].x), bf_hi(hv[m].x), bf_lo(hv[m].y), bf_hi(hv[m].y)}, h1 = {bf_lo(hv[m].z), bf_hi(hv[m].z), bf_lo(hv[m].w), bf_hi(hv[m].w)};
                        EPIOUT_ROW(m, h0, h1);
                    }
                }
#undef EPIOUT_ROW
                __builtin_amdgcn_sched_barrier(0);
            }
        }
#pragma unroll
        for (int ai = 0; ai < 2; ++ai)
#pragma unroll
            for (int m = 0; m < 4; ++m) {
                float s = ss[ai * 4 + m]; s += __shfl_xor(s, 16); s += __shfl_xor(s, 32);
                if (fq == 0) ssq[(size_t)(row0 + ai * HALF + m * 16) * 16 + u.pn * 4 + wc] = s;
            }
    }
};

struct FoldOrder {
    int G, c;
    __device__ bool next(int i, Unit& u) const { const int L = i * G + c; if (L >= 64) return false; u.pm = L >> 2; u.pn = (u.pm >> 1) * 4 + (L & 3); return true; }
    __device__ __forceinline__ void a_ready(const Unit&) const {}
    __device__ __forceinline__ void done(const Unit&) const {}
};
template <class Epi, class Sched, bool STAMP = false>
__device__ __forceinline__ void gemm_phase(PG8_LAS unsigned char* lds, const Gemm g, const Sched& S, const Epi& E, unsigned long long* stamps) {
    const int tid = opaque_tid(), wid = __builtin_amdgcn_readfirstlane(tid >> 6), lane = tid & 63, wr = wid >> 2, wc = wid & 3, fr = lane & 15, fq = lane >> 4;
    const int K = g.K, nt = K / BK;
    int ts_lo = 0, ts_hi = 0, nts = 0; const unsigned long long rt_entry = STAMP ? (unsigned long long)wall_clock64() : 0ull;
#define PG8_STAMP() do { if (STAMP && wid == 0 && nts < 64) { const unsigned long long _c = (unsigned long long)clock64(); \
        ts_lo = (lane == nts) ? (int)(unsigned)_c : ts_lo; ts_hi = (lane == nts) ? (int)(unsigned)(_c >> 32) : ts_hi; ++nts; } } while (0)
    PG8_STAMP();
    unsigned voffA[2], voffB[2];
#pragma unroll
    for (int i = 0; i < 2; ++i) { int R, C; stage_rc(tid * 16 + i * 8192, R, C); const int Rb = Epi::WIDE ? ((R >> 5) * 64 + perm32(R & 31)) : (Epi::PERM ? ((R & ~31) + perm32(R & 31)) : R);
        voffA[i] = (unsigned)(R * (g.apanel ? 256 : K) + C) * 2u; voffB[i] = (unsigned)(Rb * K + C) * 2u; }
    const size_t kstep = (size_t)(BK * 2);
    const size_t hstep = (size_t)HALF * K * 2;
    const size_t tstep = 2 * hstep;
    const size_t hstepA = g.apanel ? (size_t)HALF * 512 : hstep, tstepA = 2 * hstepA;
    const size_t pstepA = (size_t)32768 * 512;
    const size_t hstepB = Epi::WIDE ? (size_t)32 * K * 2 : hstep;
    const unsigned ldsw = (unsigned)wid * 1024u;
    const int aoff = lds_byte(wr * 64 + fr, fq * 8), boff = lds_byte(wc * 32 + fr, fq * 8);
#define PG8_SA(b, h) (((b) * 2 + (h)) * HTB)
#define PG8_SB(b, h) ((4 + (b) * 2 + (h)) * HTB)
#define PG8_STAGE(bufoff, gbase, voff) do { _Pragma("unroll") for (int _i = 0; _i < 2; ++_i) \
        __builtin_amdgcn_global_load_lds((const unsigned*)((const char*)(gbase) + (voff)[_i]), (PG8_LAS unsigned*)(lds + (bufoff) + ldsw + _i * 8192), 16, 0, 0); } while (0)
#define PG8_LDA(dst, b, h) do { _Pragma("unroll") for (int m = 0; m < 4; ++m) _Pragma("unroll") for (int k = 0; k < 2; ++k) dst[m][k] = *(const PG8_LAS bf16x8*)(lds + PG8_SA(b, h) + aoff + m * 2048 + k * 1024); } while (0)
#define PG8_LDB(dst, b, h) do { _Pragma("unroll") for (int n = 0; n < 2; ++n) _Pragma("unroll") for (int k = 0; k < 2; ++k) dst[n][k] = *(const PG8_LAS bf16x8*)(lds + PG8_SB(b, h) + boff + n * 2048 + k * 1024); } while (0)
#define PG8_MMA(ai, bj, At, Bt) do { __builtin_amdgcn_s_setprio(1); _Pragma("unroll") for (int m = 0; m < 4; ++m) _Pragma("unroll") for (int n = 0; n < 2; ++n) _Pragma("unroll") for (int k = 0; k < 2; ++k) \
        acc[ai][bj][m][n] = __builtin_amdgcn_mfma_f32_16x16x32_bf16(Bt[n][k], At[m][k], acc[ai][bj][m][n], 0, 0, 0); __builtin_amdgcn_s_setprio(0); } while (0)
#define PG8_WAIT_V(n) asm volatile("s_waitcnt vmcnt(" #n ")" ::: "memory")
#define PG8_WAIT_L(n) asm volatile("s_waitcnt lgkmcnt(" #n ")" ::: "memory")
#define PG8_BAR __builtin_amdgcn_s_barrier()
#define PG8_SCHED __builtin_amdgcn_sched_barrier(0)
    Unit cur, nxt; int ui = 0;
    if (!S.next(0, cur)) return;
    f32x4 acc[2][2][4][2];
#pragma unroll
    for (int a = 0; a < 2; ++a)
#pragma unroll
        for (int b = 0; b < 2; ++b)
#pragma unroll
            for (int m = 0; m < 4; ++m)
#pragma unroll
                for (int n = 0; n < 2; ++n) acc[a][b][m][n] = (f32x4){0.f, 0.f, 0.f, 0.f};
    bf16x8 At[4][2], B0[2][2], B1[2][2];
    const char* cA = (const char*)g.A + (size_t)cur.pm * tstepA; const char* cB = (const char*)g.Bt + (size_t)cur.pn * tstep + (size_t)(cur.pm >> 5) * g.bstride;
    S.a_ready(cur);
    PG8_STAGE(PG8_SB(0, 0), cB, voffB); PG8_STAGE(PG8_SA(0, 0), cA, voffA); PG8_STAGE(PG8_SB(0, 1), cB + hstepB, voffB); PG8_STAGE(PG8_SA(0, 1), cA + hstepA, voffA);
    if (wr == 1) PG8_BAR;
    PG8_WAIT_V(4); PG8_BAR;
    PG8_STAGE(PG8_SB(1, 0), cB + kstep, voffB); PG8_STAGE(PG8_SA(1, 0), cA + kstep, voffA); PG8_STAGE(PG8_SB(1, 1), cB + hstepB + kstep, voffB);
    PG8_WAIT_V(6); PG8_BAR;
    PG8_STAMP();
    for (;;) {
        const bool has_next = S.next(ui + 1, nxt);
        const char* nA = has_next ? (const char*)g.A + (size_t)nxt.pm * tstepA : cA; const char* nB = has_next ? (const char*)g.Bt + (size_t)nxt.pn * tstep + (size_t)(nxt.pm >> 5) * g.bstride : cB;
        for (int t = 0; t < nt; t += 2) {
            const bool last = (t == nt - 2);
            const char* a1 = cA + (g.apanel ? (size_t)(t >> 2) * pstepA + (size_t)(t & 3) * kstep : (size_t)t * kstep) + kstep;
            const char* a2 = last ? nA : cA + (g.apanel ? (size_t)((t + 2) >> 2) * pstepA + (size_t)((t + 2) & 3) * kstep : (size_t)(t + 2) * kstep); const char* b2 = last ? nB : cB + (size_t)(t + 2) * kstep;
            const char* a3 = a2 + kstep; const char* b3 = b2 + kstep;
            if (last && has_next) S.a_ready(nxt);
            PG8_LDB(B0, 0, 0); PG8_SCHED; PG8_LDA(At, 0, 0); PG8_STAGE(PG8_SA(1, 1), a1 + hstepA, voffA);
            PG8_WAIT_L(8); PG8_BAR; PG8_WAIT_L(0); PG8_MMA(0, 0, At, B0); PG8_BAR; PG8_SCHED;
            PG8_LDB(B1, 0, 1); PG8_STAGE(PG8_SB(0, 0), b2, voffB);
            PG8_BAR; PG8_WAIT_L(0); PG8_MMA(0, 1, At, B1); PG8_BAR;
            PG8_LDA(At, 0, 1); PG8_STAGE(PG8_SA(0, 0), a2, voffA);
            PG8_BAR; PG8_WAIT_L(0); PG8_MMA(1, 0, At, B0); PG8_BAR; PG8_SCHED;
            PG8_STAGE(PG8_SB(0, 1), b2 + hstepB, voffB);
            PG8_WAIT_V(6); PG8_BAR; PG8_MMA(1, 1, At, B1); PG8_BAR;
            PG8_LDB(B0, 1, 0); PG8_SCHED; PG8_LDA(At, 1, 0); PG8_STAGE(PG8_SA(0, 1), a2 + hstepA, voffA);
            PG8_WAIT_L(8); PG8_BAR; PG8_WAIT_L(0); PG8_MMA(0, 0, At, B0); PG8_BAR; PG8_SCHED;
            PG8_LDB(B1, 1, 1); PG8_STAGE(PG8_SB(1, 0), b3, voffB);
            PG8_BAR; PG8_WAIT_L(0); PG8_MMA(0, 1, At, B1); PG8_BAR;
            PG8_LDA(At, 1, 1); PG8_STAGE(PG8_SA(1, 0), a3, voffA);
            PG8_BAR; PG8_WAIT_L(0); PG8_MMA(1, 0, At, B0); PG8_BAR; PG8_SCHED;
            PG8_STAGE(PG8_SB(1, 1), b3 + hstepB, voffB);
            PG8_WAIT_V(6); PG8_BAR; PG8_MMA(1, 1, At, B1); PG8_BAR;
        }
        PG8_STAMP();
        if constexpr (!Epi::AFTER_DRAIN) { E(acc, cur, wr, wc, fr, fq, ui); S.done(cur); }
        PG8_STAMP();
        if (!has_next) break;
#pragma unroll
        for (int a = 0; a < 2; ++a)
#pragma unroll
            for (int b = 0; b < 2; ++b)
#pragma unroll
                for (int m = 0; m < 4; ++m)
#pragma unroll
                    for (int n = 0; n < 2; ++n) acc[a][b][m][n] = (f32x4){0.f, 0.f, 0.f, 0.f};
        cur = nxt; cA = nA; cB = nB; ++ui;
    }
    PG8_WAIT_V(0);
    if (wr == 0) PG8_BAR;
    PG8_BAR;
    if constexpr (Epi::AFTER_DRAIN) { E.fused(acc, cur, wr, wc, fr, fq, lds, wid, lane); S.done(cur); }
    PG8_STAMP();
    if (STAMP && wid == 0) { stamps[lane] = lane < nts ? (((unsigned long long)(unsigned)ts_hi << 32) | (unsigned)ts_lo) : 0ull;
        if (lane == 62) stamps[62] = rt_entry; if (lane == 63) stamps[63] = (unsigned long long)wall_clock64(); }
#undef PG8_STAMP
#undef PG8_SA
#undef PG8_SB
#undef PG8_STAGE
#undef PG8_LDA
#undef PG8_LDB
#undef PG8_MMA
#undef PG8_WAIT_V
#undef PG8_WAIT_L
#undef PG8_BAR
#undef PG8_SCHED
}
}

typedef unsigned short bf16_t;
typedef short bf16x8 __attribute__((ext_vector_type(8)));
typedef short s16x4 __attribute__((ext_vector_type(4)));
typedef float f32x4 __attribute__((ext_vector_type(4)));
typedef float f32x16 __attribute__((ext_vector_type(16)));
typedef unsigned u32x4 __attribute__((ext_vector_type(4)));
constexpr int MTOK = 32768, DM = 1024, EI = 2048, SEQ = 8192, NB = 4, NH = 16;
constexpr float LOG2E = 1.4426950408889634f;
constexpr float QSCALE = 0.088388347648318440f * LOG2E;
constexpr int STG_OFF = 131072 + 64, STG_SLOTS = 12;
constexpr int LDS_BYTES = STG_OFF + STG_SLOTS * 2048;
#ifndef PHMASK
#define PHMASK 0xffff
#endif
#define PH(b) ((PHMASK >> (b)) & 1)
#ifndef REP_G1
#define REP_G1 1
#endif
#ifndef REP_PG
#define REP_PG 1
#endif
#ifndef REP_G2
#define REP_G2 1
#endif
#ifndef REP_KV
#define REP_KV 1
#endif
#ifndef REP_Q
#define REP_Q 1
#endif
#ifndef REP_AT
#define REP_AT 1
#endif
#ifndef REP_P0W
#define REP_P0W 1
#endif
#ifndef REP_PRO
#define REP_PRO 1
#endif
#ifndef STAG_TICKS
#define STAG_TICKS 0
#endif
#ifndef KVQ_BAR
#define KVQ_BAR 0
#endif
#ifndef REP_SYNC
#define REP_SYNC 0
#endif
constexpr size_t MiB = 1024 * 1024;
constexpr size_t WS_R0 = 0;
constexpr size_t WS_R1 = 128 * MiB;
constexpr size_t WS_R2 = 256 * MiB;
constexpr size_t WS_H = 384 * MiB;
constexpr size_t WT_OUT = 448 * MiB, WT_BOUT = WT_OUT + 2 * 4 * MiB;
constexpr size_t WS_WTB0 = WT_BOUT + 2 * 4 * MiB;
constexpr size_t WS_SSQ = WS_WTB0 + 32 * MiB;
constexpr size_t WS_MOD = WS_SSQ + 2 * MiB;
constexpr size_t MOD_BYTES = (4 * 4 * 3072 + 4 * 2048) * 4;
constexpr size_t WS_BAR = WS_MOD + MOD_BYTES;
constexpr size_t ZERO_BYTES = 256 * 1024;
constexpr size_t WS_GS = WS_MOD + 256 * 1024;
constexpr size_t WS_SW = WS_GS + 128 * 1024;
constexpr size_t WS_END = WS_SW + 512 * 1024;
constexpr size_t WS_WGT = WS_R2;
constexpr size_t WS_BFOLD = WS_R2 + 4 * MiB;
constexpr size_t WT_IN = WS_R1, WT_KV = WT_IN + 2 * 8 * MiB, WT_BIN = WT_KV + 8 * MiB;
static_assert(WS_END <= 512 * MiB, "workspace");

struct Params {
    const float* x; const float* c; const float* ada_w; const float* ada_b; const float* norm_g; const float* a_w_in; const float* a_w_group; const float* a_scale; const float* a_w_out;
    const float* kv_norm_g; const float* kv_ada_w; const float* kv_ada_b; const float* w_kv; const float* b_w_in; const float* b_rel_bias; const float* b_w_out; const float* final_g;
    float* out; unsigned char* ws;
};

#if defined(__HIP_DEVICE_COMPILE__)
__device__ __forceinline__ Params kparams() {
    typedef const float* __attribute__((address_space(4))) * KArgs;
    KArgs p = (KArgs)__builtin_amdgcn_kernarg_segment_ptr(); asm volatile("" : "+s"(p));
    Params r; r.x = p[0]; r.c = p[1]; r.ada_w = p[2]; r.ada_b = p[3]; r.norm_g = p[4]; r.a_w_in = p[5]; r.a_w_group = p[6]; r.a_scale = p[7]; r.a_w_out = p[8];
    r.kv_norm_g = p[9]; r.kv_ada_w = p[10]; r.kv_ada_b = p[11]; r.w_kv = p[12]; r.b_w_in = p[13]; r.b_rel_bias = p[14]; r.b_w_out = p[15]; r.final_g = p[16];
    r.out = (float*)p[17]; r.ws = (unsigned char*)p[18]; return r; }
#else
__device__ __forceinline__ Params kparams() { return Params{}; }
#endif
#define PHASE_BEGIN const Params P = kparams(); unsigned char* ws = P.ws; (void)ws; int G = gridDim.x, bx = blockIdx.x; asm volatile("" : "+s"(G), "+s"(bx)); const int vcu = (G % 8 == 0) ? (bx % 8) * (G / 8) + bx / 8 : bx; (void)vcu; \
    float* ssq = (float*)(ws + WS_SSQ); const float* mod = (const float*)(ws + WS_MOD); const float* gs = (const float*)(ws + WS_GS); const float* sw = (const float*)(ws + WS_SW); \
    bf16_t* R0 = (bf16_t*)(ws + WS_R0); bf16_t* R1 = (bf16_t*)(ws + WS_R1); bf16_t* R2 = (bf16_t*)(ws + WS_R2); bf16_t* H16 = (bf16_t*)(ws + WS_H); \
    (void)ssq; (void)mod; (void)gs; (void)sw; (void)R0; (void)R1; (void)R2; (void)H16;
__device__ __forceinline__ unsigned cvtpk(float lo, float hi) { unsigned r; asm volatile("v_cvt_pk_bf16_f32 %0, %1, %2" : "=v"(r) : "v"(lo), "v"(hi)); return r; }
__device__ __forceinline__ float bflo(unsigned w) { return __uint_as_float(w << 16); }
__device__ __forceinline__ float bfhi(unsigned w) { return __uint_as_float(w & 0xffff0000u); }
__device__ __forceinline__ float wave_sum(float v) {
#pragma unroll
    for (int o = 32; o >= 1; o >>= 1) v += __shfl_xor(v, o);
    return v;
}

namespace att {
#define KSWZ(row, colB) ((row) * 256 + ((colB) ^ (((row) & 7) << 4)))
#define SBAR() __builtin_amdgcn_sched_barrier(0)
__device__ __forceinline__ int crow(int r, int hi) { return (r & 3) + 8 * (r >> 2) + 4 * hi; }
__device__ __forceinline__ void qkt(f32x16& p0, f32x16& p1, const char* Ks, const bf16x8* qr, int r32, int hi) {
    p0 = f32x16{}; p1 = f32x16{};
#pragma unroll
    for (int d0 = 0; d0 < 8; ++d0) { const int cb = (d0 * 16 + hi * 8) * 2;
        const bf16x8 b0 = *reinterpret_cast<const bf16x8*>(Ks + KSWZ(r32, cb));
        const bf16x8 b1 = *reinterpret_cast<const bf16x8*>(Ks + KSWZ(32 + r32, cb));
        p0 = __builtin_amdgcn_mfma_f32_32x32x16_bf16(b0, qr[d0], p0, 0, 0, 0);
        p1 = __builtin_amdgcn_mfma_f32_32x32x16_bf16(b1, qr[d0], p1, 0, 0, 0); }
}
__device__ __forceinline__ int v_st(int k, int c) { const int kk = (k & ~0xC) | ((k & 4) << 1) | ((k & 8) >> 1); return ((kk >> 3) * 4 + (c >> 5)) * 512 + ((kk & 7) * 32 + (c & 31)) * 2; }
__device__ __forceinline__ int v_rd_base(int lane) { return ((lane & 3) << 3) | (((lane >> 2) & 3) << 6) | (((lane >> 4) & 1) << 5) | (((lane >> 5) & 1) << 8); }
constexpr int v_rd_off(int d0, int ks, int half) { return d0 * 512 + ks * 4096 + half * 2048; }
template <int OFF> __device__ __forceinline__ s16x4 tr_read(int vb) {
    s16x4 r; asm volatile("ds_read_b64_tr_b16 %0, %1 offset:%2" : "=&v"(r) : "v"(vb), "i"(OFF) : "memory"); return r;
}
template <int D0> __device__ __forceinline__ void pv_one(f32x16& od, int vb, bf16x8 pa0, bf16x8 pa1, bf16x8 pa2, bf16x8 pa3) {
    const s16x4 l0 = tr_read<v_rd_off(D0, 0, 0)>(vb), h0 = tr_read<v_rd_off(D0, 0, 1)>(vb), l1 = tr_read<v_rd_off(D0, 1, 0)>(vb), h1 = tr_read<v_rd_off(D0, 1, 1)>(vb);
    const s16x4 l2 = tr_read<v_rd_off(D0, 2, 0)>(vb), h2 = tr_read<v_rd_off(D0, 2, 1)>(vb), l3 = tr_read<v_rd_off(D0, 3, 0)>(vb), h3 = tr_read<v_rd_off(D0, 3, 1)>(vb);
    asm volatile("s_waitcnt lgkmcnt(0)" ::: "memory"); SBAR();
#define PK(L, H) (bf16x8){L[0], L[1], L[2], L[3], H[0], H[1], H[2], H[3]}
    od = __builtin_amdgcn_mfma_f32_32x32x16_bf16(pa0, PK(l0, h0), od, 0, 0, 0);
    od = __builtin_amdgcn_mfma_f32_32x32x16_bf16(pa1, PK(l1, h1), od, 0, 0, 0);
    od = __builtin_amdgcn_mfma_f32_32x32x16_bf16(pa2, PK(l2, h2), od, 0, 0, 0);
    od = __builtin_amdgcn_mfma_f32_32x32x16_bf16(pa3, PK(l3, h3), od, 0, 0, 0);
#undef PK
}
constexpr float THR2 = 11.0f;

__device__ __forceinline__ void partialSM(f32x16& p0, f32x16& p1, float& m_reg, float& alpha, float cb) {
    float pmax = p0[0];
#pragma unroll
    for (int r = 1; r < 16; ++r) pmax = fmaxf(pmax, p0[r]);
#pragma unroll
    for (int r = 0; r < 16; ++r) pmax = fmaxf(pmax, p1[r]);
    { auto rr = __builtin_amdgcn_permlane32_swap(__float_as_uint(pmax), __float_as_uint(pmax), false, false);
      pmax = fmaxf(__uint_as_float(rr[0]), __uint_as_float(rr[1])); }
    pmax += cb;
    float mn;
    if (__all(pmax - m_reg <= THR2)) { mn = m_reg; alpha = 1.f; }
    else { mn = fmaxf(m_reg, pmax); alpha = __builtin_amdgcn_exp2f(m_reg - mn); m_reg = mn; }
    const float mnc = mn - cb;
    p0 = p0 - mnc; p1 = p1 - mnc;
#pragma unroll
    for (int r = 0; r < 16; ++r) p0[r] = __builtin_amdgcn_exp2f(p0[r]);
}
__device__ __forceinline__ void finishSM(f32x16& p0, f32x16& p1, float alpha, float& l_reg, bf16x8& pa0, bf16x8& pa1, bf16x8& pa2, bf16x8& pa3) {
#pragma unroll
    for (int r = 0; r < 16; ++r) p1[r] = __builtin_amdgcn_exp2f(p1[r]);
    const f32x16 s16 = p0 + p1;
    float ps = ((s16[0] + s16[1]) + (s16[2] + s16[3])) + ((s16[4] + s16[5]) + (s16[6] + s16[7])) + (((s16[8] + s16[9]) + (s16[10] + s16[11])) + ((s16[12] + s16[13]) + (s16[14] + s16[15])));
    { auto rr = __builtin_amdgcn_permlane32_swap(__float_as_uint(ps), __float_as_uint(ps), false, false);
      ps = __uint_as_float(rr[0]) + __uint_as_float(rr[1]); }
    l_reg = l_reg * alpha + ps;
#define PK4(P, BASE, OUT) do { unsigned a0 = cvtpk(P[BASE + 0], P[BASE + 1]), a1 = cvtpk(P[BASE + 2], P[BASE + 3]);   \
    unsigned b0 = cvtpk(P[BASE + 4], P[BASE + 5]), b1 = cvtpk(P[BASE + 6], P[BASE + 7]);                              \
    auto r0 = __builtin_amdgcn_permlane32_swap(a0, b0, false, false); auto r1 = __builtin_amdgcn_permlane32_swap(a1, b1, false, false); \
    u32x4 w = {r0[0], r1[0], r0[1], r1[1]}; OUT = *reinterpret_cast<bf16x8*>(&w); } while (0)
    PK4(p0, 0, pa0); PK4(p0, 8, pa1); PK4(p1, 0, pa2); PK4(p1, 8, pa3);
#undef PK4
}
__device__ __forceinline__ void add_bias(f32x16& p0, f32x16& p1, const float* tl) {
    f32x16 t0, t1;
#pragma unroll
    for (int r = 0; r < 16; ++r) { const int c = (r & 3) + 8 * (r >> 2); t0[r] = tl[59 - c]; t1[r] = tl[27 - c]; }
    p0 = p0 + t0; p1 = p1 + t1;
}

__device__ __forceinline__ void attn_phase(char* lds, PG8_LAS unsigned char* l3, bf16_t* Qio, const bf16_t* Kb, const bf16_t* Vb, const float* relb, int vcu, int G, bool store) {
    const int wid = __builtin_amdgcn_readfirstlane(opaque_tid() >> 6);
    float* wsf = (float*)(lds + 98304) + wid * 64; float* li_l = wsf; float* al_l = wsf + 32;
    float* tb = (float*)(lds + 98304 + 2048);
    const int ci = wid >> 1;
    for (int it = vcu; it < 2048; it += G) {
        const int tid = opaque_tid(), lane = tid & 63, r32 = lane & 31, hi = lane >> 5;
        const int vb0 = (int)(uintptr_t)lds + 16384 + v_rd_base(lane);
        const int qrow = (wid & 1) * 32 + r32;
        const int cgp = it & 31, bh = it >> 5, h = bh & 15, b = bh >> 4, c0 = cgp * 4;
        if (tid < 320) tb[tid] = relb[h * 257 + (tid < 256 ? tid : 256)] * LOG2E;
        bf16_t* Qw = Qio + ((size_t)(h >> 1) * MTOK + (b * SEQ + c0 * 64 + wid * 32)) * 256 + (h & 1) * 128;
        const bf16_t* Kh = Kb + (size_t)(b * NH + h) * SEQ * 128; const bf16_t* Vh = Vb + (size_t)(b * NH + h) * SEQ * 128;
        int kof[2], vof[2];
#pragma unroll
        for (int i = 0; i < 2; ++i) { const int Pb = wid * 1024 + lane * 16 + i * 8192;
            { const int row = Pb >> 8, cB = (Pb & 255) ^ ((row & 7) << 4); kof[i] = row * 128 + (cB >> 1); }
            { const int sub = Pb >> 9, within = Pb & 511, kk = (sub >> 2) * 8 + (within >> 6), c = (sub & 3) * 32 + ((within & 63) >> 1);
              const int k = (kk & ~0xC) | ((kk & 4) << 1) | ((kk & 8) >> 1); vof[i] = k * 128 + c; } }
        bf16x8 qr[8];
#pragma unroll
        for (int d0 = 0; d0 < 8; ++d0) qr[d0] = *(const bf16x8*)(Qw + (size_t)r32 * 256 + hi * 8 + d0 * 16);
        float m_reg = -1e30f, l_reg = 0.f; f32x16 o[4] = {};
#define GLOAD(k0, slot) do { const bf16_t* kt_ = Kh + (size_t)(k0) * 128; const bf16_t* vt_ = Vh + (size_t)(k0) * 128; _Pragma("unroll") for (int i_ = 0; i_ < 2; ++i_) { \
        __builtin_amdgcn_global_load_lds((const unsigned*)(kt_ + kof[i_]), (PG8_LAS unsigned*)(l3 + (slot) + wid * 1024 + i_ * 8192), 16, 0, 0); \
        __builtin_amdgcn_global_load_lds((const unsigned*)(vt_ + vof[i_]), (PG8_LAS unsigned*)(l3 + (slot) + 16384 + wid * 1024 + i_ * 8192), 16, 0, 0); } } while (0)
#define RESC(a) do { if (__any((a) < 1.f)) { if (hi == 0) al_l[r32] = (a); asm volatile("s_waitcnt lgkmcnt(0)" ::: "memory"); \
        _Pragma("unroll") for (int r = 0; r < 16; ++r) { const float a_ = al_l[crow(r, hi)]; _Pragma("unroll") for (int d = 0; d < 4; ++d) o[d][r] *= a_; } } } while (0)
        const int jstart = (8 - c0) > 0 ? (8 - c0) : 0;
        const int lo = ci > jstart ? ci : jstart, hiw = ci + 8;
        const int hlo = (ci & 2) > jstart ? (ci & 2) : jstart, hhi = (ci & 2) + 10;
        int sc = 0, sp = 65536, sn = 32768;
        GLOAD((c0 - 8 + jstart) * 64, 0); asm volatile("s_waitcnt vmcnt(0)" ::: "memory");
        __syncthreads();
        const float tbclip = tb[256];
        f32x16 pA0 = {}, pA1, pB0 = {}, pB1; float alA = 1.f, alB = 1.f;
#pragma unroll
        for (int r = 0; r < 16; ++r) { pA1[r] = -3e30f; pB1[r] = -3e30f; }
#define ATT_PV() do { const int vb = vb0 + sp; pv_one<0>(o[0], vb, pa0, pa1, pa2, pa3); pv_one<1>(o[1], vb, pa0, pa1, pa2, pa3); pv_one<2>(o[2], vb, pa0, pa1, pa2, pa3); pv_one<3>(o[3], vb, pa0, pa1, pa2, pa3); } while (0)
#define ATT_STEP(PC0, PC1, ALC, PP0, PP1, ALP) do { \
        SBAR(); \
        { const int jn = (j + 1 < 12) ? j + 1 : 11; GLOAD((c0 - 8 + jn) * 64, sn); }        \
        SBAR(); \
        if (j >= hlo && j <= hhi) {        \
            bf16x8 pa0, pa1, pa2, pa3; \
            const int dc = (j >= lo && j <= hiw) ? ci + 8 - j : -1; \
            const float cb = dc < 0 ? -3e30f : (dc >= 3 ? tbclip : 0.f); \
            qkt(PC0, PC1, lds + sc, qr, r32, hi); finishSM(PP0, PP1, ALP, l_reg, pa0, pa1, pa2, pa3); \
            SBAR(); \
            ATT_PV(); \
            if (dc >= 0 && dc <= 2) add_bias(PC0, PC1, tb + (64 * dc + 128 + qrow - 4 * hi - 59)); \
            partialSM(PC0, PC1, m_reg, ALC, cb); RESC(ALC); \
        } else ALC = 1.f; \
        asm volatile("s_waitcnt vmcnt(0)" ::: "memory"); \
        __syncthreads(); \
        { const int t_ = sp; sp = sc; sc = sn; sn = t_; } \
    } while (0)
        { const int j = jstart; ATT_STEP(pB0, pB1, alB, pA0, pA1, alA); }
        for (int j = jstart + 1; j < 13; ++j) {
            ATT_STEP(pA0, pA1, alA, pB0, pB1, alB); ++j;
            ATT_STEP(pB0, pB1, alB, pA0, pA1, alA);
        }
#undef ATT_STEP
#undef ATT_PV
#undef GLOAD
#undef RESC
        if (hi == 0) li_l[r32] = l_reg; asm volatile("s_waitcnt lgkmcnt(0)" ::: "memory");
        { const int le = opaque_tid() & 63, er32 = le & 31, ehi = le >> 5; const bool ev = (le & 1) == 0;
          bf16_t* Qe = store ? Qw + (er32 & ~1) + (size_t)(4 * ehi + (ev ? 0 : 1)) * 256 : nullptr;
          if (Qe) {
#pragma unroll
          for (int r = 0; r < 16; r += 2) {
            const float rl0 = __builtin_amdgcn_rcpf(li_l[crow(r, ehi)]), rl1 = __builtin_amdgcn_rcpf(li_l[crow(r + 1, ehi)]);
#pragma unroll
            for (int d0 = 0; d0 < 4; ++d0) {
                const float x0 = o[d0][r] * rl0, x1 = o[d0][r + 1] * rl1;
                const float snd = ev ? x1 : x0, keep = ev ? x0 : x1;
                const float got = __int_as_float(__builtin_amdgcn_mov_dpp(__float_as_int(snd), 0xB1, 0xF, 0xF, true));
                const unsigned w = ev ? cvtpk(keep, got) : cvtpk(got, keep);
                *(unsigned*)(Qe + (size_t)((r & 3) + 8 * (r >> 2)) * 256 + d0 * 32) = w;
            }
          } }
        }
    }
}
}

__device__ __forceinline__ void p0_mod(const Params& P, char* lds, int bx) {
    float* cact = (float*)lds;
    float* part = (float*)(lds + 16384);
    const int tid = opaque_tid();
    if (bx >= 224) return;
    for (int i = tid; i < 4096; i += 512) { const float v = P.c[i]; cact[i] = v * __builtin_amdgcn_rcpf(1.0f + __builtin_amdgcn_exp2f(-LOG2E * v)); }
    __syncthreads();
    const float* W; const float* bias; float* outp; int pitch, j0;
    float* mod = (float*)(P.ws + WS_MOD);
    if (bx < 192) { const int l = bx / 48; j0 = (bx % 48) * 64; W = P.ada_w + (size_t)l * 1024 * 3072; pitch = 3072; bias = P.ada_b + l * 3072; outp = mod + l * 4 * 3072; }
    else { j0 = (bx - 192) * 64; W = P.kv_ada_w; pitch = 2048; bias = P.kv_ada_b; outp = mod + 4 * 4 * 3072; }
    const int jl = tid & 63, kq = tid >> 6, j = j0 + jl; float a0 = 0.f, a1 = 0.f, a2 = 0.f, a3 = 0.f;
    const float* wp = W + (size_t)(kq * 128) * pitch + j;
#pragma unroll 16
    for (int k = 0; k < 128; ++k) { const float w = wp[(size_t)k * pitch]; const int kk = kq * 128 + k; a0 += cact[kk] * w; a1 += cact[1024 + kk] * w; a2 += cact[2048 + kk] * w; a3 += cact[3072 + kk] * w; }
    part[(kq * 4 + 0) * 64 + jl] = a0; part[(kq * 4 + 1) * 64 + jl] = a1; part[(kq * 4 + 2) * 64 + jl] = a2; part[(kq * 4 + 3) * 64 + jl] = a3;
    __syncthreads();
    if (tid < 256) { const int b = tid >> 6; float s = 0.f;
#pragma unroll
        for (int q = 0; q < 8; ++q) s += part[(q * 4 + b) * 64 + jl];
        outp[b * pitch + j] = s + bias[j]; }
    __syncthreads();
}

__device__ __forceinline__ void transpose_tile(const float* src, int spitch, bf16_t* dst, int dpitch, int r0, int c0, char* lds) {
    bf16_t* tile = (bf16_t*)lds;
    const int tid = opaque_tid();
    { const int rr = tid >> 4, c4 = (tid & 15) * 4;
#pragma unroll
      for (int p = 0; p < 4; ++p) { const int r = p * 32 + rr; const f32x4 v = *(const f32x4*)(src + (size_t)(r0 + r) * spitch + c0 + c4);
          const unsigned w0 = cvtpk(v[0], v[1]), w1 = cvtpk(v[2], v[3]);
          tile[(c4 + 0) * 136 + r] = (bf16_t)(w0 & 0xffffu); tile[(c4 + 1) * 136 + r] = (bf16_t)(w0 >> 16); tile[(c4 + 2) * 136 + r] = (bf16_t)(w1 & 0xffffu); tile[(c4 + 3) * 136 + r] = (bf16_t)(w1 >> 16); } }
    __syncthreads();
    { const int c = tid >> 4, r8 = (tid & 15) * 8;
#pragma unroll
      for (int p = 0; p < 2; ++p) { const int cc = p * 32 + c; const u32x4 w = *(const u32x4*)(tile + cc * 136 + r8); *(u32x4*)(dst + (size_t)(c0 + cc) * dpitch + r0 + r8) = w; } }
    __syncthreads();
}
__device__ __forceinline__ void p0_weights(const Params& P, char* lds, int bx, int G) {
    unsigned char* ws = P.ws;
    for (int t = bx; t < 3328; t += G) {
        const float* src; bf16_t* dst; int spitch, dpitch, ntc, tt;
        if (t < 512) { const int l = t >> 8; tt = t & 255; src = P.a_w_in + (size_t)l * 1024 * 4096 + 2048; spitch = 4096; dst = (bf16_t*)(ws + WT_IN + l * 8 * MiB) + (size_t)2048 * 1024; dpitch = 1024; ntc = 32; }
        else if (t < 1024) { const int l = (t - 512) >> 8; tt = t & 255; src = P.a_w_out + (size_t)l * 2048 * 1024; spitch = 1024; dst = (bf16_t*)(ws + WT_OUT + l * 4 * MiB); dpitch = 2048; ntc = 16; }
        else if (t < 1536) { tt = t - 1024; src = P.w_kv; spitch = 4096; dst = (bf16_t*)(ws + WT_KV); dpitch = 1024; ntc = 64; }
        else if (t < 2560) { const int l = (t - 1536) >> 9; tt = (t - 1536) & 511; src = P.b_w_in + (size_t)l * 1024 * 4096; spitch = 4096; dst = (bf16_t*)(ws + WT_BIN + l * 8 * MiB); dpitch = 1024; ntc = 64; }
        else if (t < 3072) { const int l = (t - 2560) >> 8; tt = t & 255; src = P.b_w_out + (size_t)l * 2048 * 1024; spitch = 1024; dst = (bf16_t*)(ws + WT_BOUT + l * 4 * MiB); dpitch = 2048; ntc = 16; }
        else { const int lg = (t - 3072) >> 5; tt = t & 31; src = P.a_w_group + (size_t)lg * 512 * 512; spitch = 512; dst = (bf16_t*)(ws + WS_WGT) + (size_t)lg * 512 * 512; dpitch = 512; ntc = 8; }
        const int tr = tt / ntc, tc = tt % ntc;
        transpose_tile(src, spitch, dst, dpitch, tr * 128, tc * 64, lds);
    }
    bf16_t* bf = (bf16_t*)(ws + WS_BFOLD);
    for (int i = bx * 512 + opaque_tid(); i < 2 * 4 * 1024 * 64; i += G * 512) {
        const int j8 = i & 63, k = (i >> 6) & 1023, lg = i >> 16, l = lg >> 2, g = lg & 3;
        const float* s = P.a_w_in + ((size_t)l * 1024 + k) * 4096 + g * 512 + j8 * 8;
        const f32x4 v0 = *(const f32x4*)s, v1 = *(const f32x4*)(s + 4);
        u32x4 w; w.x = cvtpk(v0[0], v0[1]); w.y = cvtpk(v0[2], v0[3]); w.z = cvtpk(v1[0], v1[1]); w.w = cvtpk(v1[2], v1[3]);
        *(u32x4*)(bf + (size_t)i * 8) = w;
    }
}

__device__ __forceinline__ void p1_gs(const Params& P) {
    const float* mod = (const float*)(P.ws + WS_MOD); float* gs = (float*)(P.ws + WS_GS);
    for (int i = opaque_tid(); i < 5 * 4096; i += 512) {
        const int idx = i >> 12, b = (i >> 10) & 3, c = i & 1023;
        const float g = idx < 4 ? P.norm_g[idx * 1024 + c] : P.kv_norm_g[c];
        const float sc = idx < 4 ? mod[(idx * 4 + b) * 3072 + 1024 + c] : mod[4 * 4 * 3072 + b * 2048 + 1024 + c];
        gs[i] = g * (1.0f + sc);
    }
}
__device__ __forceinline__ void p1_prep(const Params& P, int bx, int G) {
    float* ssq = (float*)(P.ws + WS_SSQ); bf16_t* h16 = (bf16_t*)(P.ws + WS_H);
    const int tid = opaque_tid(); const int wid = tid >> 6, lane = tid & 63;
    for (int rp = bx * 8 + wid; rp < MTOK / 2; rp += G * 8) {
        f32x4 v[2][4];
#pragma unroll
        for (int q = 0; q < 2; ++q)
#pragma unroll
            for (int k = 0; k < 2; ++k) { const float* xp = P.x + (size_t)(rp * 2 + q) * 1024 + k * 512 + lane * 8; v[q][2 * k] = *(const f32x4*)xp; v[q][2 * k + 1] = *(const f32x4*)(xp + 4); }
#pragma unroll
        for (int q = 0; q < 2; ++q) { const int row = rp * 2 + q; float s = 0.f;
#pragma unroll
            for (int k = 0; k < 2; ++k) { const f32x4 v0 = v[q][2 * k], v1 = v[q][2 * k + 1];
                s += ((v0[0] * v0[0] + v0[1] * v0[1]) + (v0[2] * v0[2] + v0[3] * v0[3])) + ((v1[0] * v1[0] + v1[1] * v1[1]) + (v1[2] * v1[2] + v1[3] * v1[3]));
                u32x4 w; w.x = cvtpk(v0[0], v0[1]); w.y = cvtpk(v0[2], v0[3]); w.z = cvtpk(v1[0], v1[1]); w.w = cvtpk(v1[2], v1[3]);
                *(u32x4*)(h16 + ((size_t)(2 * k + (lane >> 5)) * MTOK + row) * 256 + (lane & 31) * 8) = w; }
            s = wave_sum(s);
            if (lane < 16) ssq[(size_t)row * 16 + lane] = lane == 0 ? s : 0.f; }
    }
}
__device__ __forceinline__ void p2_scale(const Params& P, int bx, int G) {
    const float* gs = (const float*)(P.ws + WS_GS);
    for (int i0 = bx * 512 + opaque_tid(); i0 < 5 * 4096 * 64; i0 += G * 512) {
        u32x4 w[2]; int k8[2], n[2], widx[2];
#pragma unroll
        for (int q = 0; q < 2; ++q) { const int i = i0 + q * (5 * 4096 * 64); k8[q] = i & 127; n[q] = (i >> 7) & 4095; widx[q] = i >> 19;
            const bf16_t* Wt = (const bf16_t*)(P.ws + (widx[q] < 2 ? WT_IN + widx[q] * 8 * MiB : (widx[q] < 4 ? WT_BIN + (widx[q] - 2) * 8 * MiB : WT_KV)));
            w[q] = *(const u32x4*)(Wt + (size_t)n[q] * 1024 + k8[q] * 8); }
#pragma unroll
        for (int q = 0; q < 2; ++q) {
            bf16_t* dst = widx[q] == 0 ? (bf16_t*)(P.ws + WS_WTB0) : (bf16_t*)((unsigned char*)P.out + (size_t)(widx[q] - 1) * 32 * MiB);
            const float wv[8] = {bflo(w[q].x), bfhi(w[q].x), bflo(w[q].y), bfhi(w[q].y), bflo(w[q].z), bfhi(w[q].z), bflo(w[q].w), bfhi(w[q].w)};
#pragma unroll
            for (int b = 0; b < 4; ++b) {
                const f32x4 g0 = *(const f32x4*)(gs + (widx[q] * 4 + b) * 1024 + k8[q] * 8), g1 = *(const f32x4*)(gs + (widx[q] * 4 + b) * 1024 + k8[q] * 8 + 4);
                u32x4 o; o.x = cvtpk(wv[0] * g0[0], wv[1] * g0[1]); o.y = cvtpk(wv[2] * g0[2], wv[3] * g0[3]); o.z = cvtpk(wv[4] * g1[0], wv[5] * g1[1]); o.w = cvtpk(wv[6] * g1[2], wv[7] * g1[3]);
                *(u32x4*)(dst + ((size_t)b * 4096 + n[q]) * 1024 + k8[q] * 8) = o;
            }
        }
    }
}

__device__ __forceinline__ void p2_sw(const Params& P, char* lds, int bx, int G) {
    float* sh = (float*)lds;
    const float* mod = (const float*)(P.ws + WS_MOD); float* sw = (float*)(P.ws + WS_SW);
    const int tid = opaque_tid(), wid = tid >> 6, lane = tid & 63;
    int curw = -1;
    for (int it = bx; it < 5 * 128; it += G) {
        const int widx = it >> 7, n0 = (it & 127) * 32;
        if (widx != curw) { curw = widx; __syncthreads();
            for (int i = tid; i < 4096; i += 512) { const int b = i >> 10, k = i & 1023;
                const int layer = widx < 2 ? widx : (widx < 4 ? widx : -1);
                sh[i] = widx < 4 ? mod[(layer * 4 + b) * 3072 + k] : mod[4 * 4 * 3072 + b * 2048 + k]; }
            __syncthreads(); }
        const bf16_t* Wt = (const bf16_t*)(P.ws + (widx < 2 ? WT_IN + widx * 8 * MiB : (widx < 4 ? WT_BIN + (widx - 2) * 8 * MiB : WT_KV)));
#pragma unroll 1
        for (int q = 0; q < 4; ++q) { const int n = n0 + wid * 4 + q;
            const u32x4 w0 = *(const u32x4*)(Wt + (size_t)n * 1024 + lane * 16), w1 = *(const u32x4*)(Wt + (size_t)n * 1024 + lane * 16 + 8);
            float wv[16] = {bflo(w0.x), bfhi(w0.x), bflo(w0.y), bfhi(w0.y), bflo(w0.z), bfhi(w0.z), bflo(w0.w), bfhi(w0.w), bflo(w1.x), bfhi(w1.x), bflo(w1.y), bfhi(w1.y), bflo(w1.z), bfhi(w1.z), bflo(w1.w), bfhi(w1.w)};
            float a[4];
#pragma unroll
            for (int b = 0; b < 4; ++b) { float s = 0.f;
#pragma unroll
                for (int k4 = 0; k4 < 4; ++k4) { const f32x4 sv = *(const f32x4*)(sh + b * 1024 + lane * 16 + k4 * 4); s += sv[0] * wv[k4 * 4] + sv[1] * wv[k4 * 4 + 1] + sv[2] * wv[k4 * 4 + 2] + sv[3] * wv[k4 * 4 + 3]; }
                a[b] = wave_sum(s); }
            if (lane == 0) { sw[(widx * 4 + 0) * 4096 + n] = a[0]; sw[(widx * 4 + 1) * 4096 + n] = a[1]; sw[(widx * 4 + 2) * 4096 + n] = a[2]; sw[(widx * 4 + 3) * 4096 + n] = a[3]; } }
    }
    __syncthreads();
}

__device__ __forceinline__ void pool_gate(char* lds, const bf16_t* vg, const bf16_t* sz, bf16_t* outp, const float* a_scale, int bx, int G) {
    const int tid = opaque_tid(), wid = tid >> 6, lane = tid & 63;
    const int r0 = wid * 8;
    u32x4 st[10], zr[8];
#define PG_FETCH(IT) do { const int g_ = (IT) & 3, m0_ = ((IT) >> 2) * 64, t0_ = m0_ & (SEQ - 1); \
        _Pragma("unroll") for (int k = 0; k < 10; ++k) { const int p = tid + k * 512, lr = p >> 6, c16 = p & 63; u32x4 v = {0u, 0u, 0u, 0u}; \
            if (p < 79 * 64 && (t0_ + lr - 15) >= 0) v = *(const u32x4*)(vg + ((size_t)(2 * g_ + (c16 >> 5)) * MTOK + (m0_ + lr - 15)) * 256 + (c16 & 31) * 8); st[k] = v; } \
        _Pragma("unroll") for (int r = 0; r < 8; ++r) zr[r] = *(const u32x4*)(sz + ((size_t)(2 * g_ + (lane >> 5)) * MTOK + (m0_ + r0 + r)) * 256 + (lane & 31) * 8); } while (0)
    if (bx < 2048) PG_FETCH(bx);
    for (int it = bx; it < 2048; it += G) {
        const int g = it & 3, rt = it >> 2, m0 = rt * 64, t0 = m0 & (SEQ - 1), w = 2 << g;
        __syncthreads();
#pragma unroll
        for (int k = 0; k < 10; ++k) { const int p = tid + k * 512; if (p < 79 * 64) *(u32x4*)(lds + (size_t)p * 16) = st[k]; }
        u32x4 zc[8];
#pragma unroll
        for (int r = 0; r < 8; ++r) zc[r] = zr[r];
        __syncthreads();
        if (it + G < 2048) PG_FETCH(it + G);
        const int e = g * 512 + lane * 8;
        const f32x4 as0 = *(const f32x4*)(a_scale + e), as1 = *(const f32x4*)(a_scale + e + 4);
        float ws8[8];
#pragma unroll
        for (int i = 0; i < 8; ++i) ws8[i] = 0.f;
        for (int k = 1; k < w; ++k) { const u32x4 v = *(const u32x4*)(lds + (size_t)(r0 + 15 - k) * 1024 + lane * 16);
            ws8[0] += bflo(v.x); ws8[1] += bfhi(v.x); ws8[2] += bflo(v.y); ws8[3] += bfhi(v.y); ws8[4] += bflo(v.z); ws8[5] += bfhi(v.z); ws8[6] += bflo(v.w); ws8[7] += bfhi(v.w); }
#pragma unroll
        for (int r = 0; r < 8; ++r) {
            const int lr = r0 + r + 15;
            const u32x4 v = *(const u32x4*)(lds + (size_t)lr * 1024 + lane * 16);
            const float x[8] = {bflo(v.x), bfhi(v.x), bflo(v.y), bfhi(v.y), bflo(v.z), bfhi(v.z), bflo(v.w), bfhi(v.w)};
#pragma unroll
            for (int i = 0; i < 8; ++i) ws8[i] += x[i];
            const int t = t0 + r0 + r; const int cnt = (t + 1) < w ? (t + 1) : w; const float inv = 1.0f / (float)cnt;
            const size_t off = ((size_t)(2 * g + (lane >> 5)) * MTOK + (m0 + r0 + r)) * 256 + (lane & 31) * 8;
            const u32x4 z = zc[r];
            float zz[8] = {bflo(z.x), bfhi(z.x), bflo(z.y), bfhi(z.y), bflo(z.z), bfhi(z.z), bflo(z.w), bfhi(z.w)};
#pragma unroll
            for (int i = 0; i < 8; ++i) zz[i] = zz[i] * __builtin_amdgcn_rcpf(1.0f + __builtin_amdgcn_exp2f(-LOG2E * zz[i]));
            float o[8];
#pragma unroll
            for (int i = 0; i < 8; ++i) o[i] = (ws8[i] * inv - x[i]) * (i < 4 ? as0[i & 3] : as1[i & 3]) * zz[i];
            u32x4 wv; wv.x = cvtpk(o[0], o[1]); wv.y = cvtpk(o[2], o[3]); wv.z = cvtpk(o[4], o[5]); wv.w = cvtpk(o[6], o[7]);
            *(u32x4*)(outp + off) = wv;
            const u32x4 d = *(const u32x4*)(lds + (size_t)(lr - w + 1) * 1024 + lane * 16);
            ws8[0] -= bflo(d.x); ws8[1] -= bfhi(d.x); ws8[2] -= bflo(d.y); ws8[3] -= bfhi(d.y); ws8[4] -= bflo(d.z); ws8[5] -= bfhi(d.z); ws8[6] -= bflo(d.w); ws8[7] -= bfhi(d.w);
        }
    }
#undef PG_FETCH
    __syncthreads();
}

__device__ __forceinline__ void final_norm(const Params& P, int bx, int G) {
    const float* ssq = (const float*)(P.ws + WS_SSQ); const bf16_t* h16 = (const bf16_t*)(P.ws + WS_H);
    const int tid = opaque_tid(); const int wid = tid >> 6, lane = tid & 63;
    f32x4 g[4];
#pragma unroll
    for (int k = 0; k < 2; ++k) { g[2 * k] = *(const f32x4*)(P.final_g + k * 512 + lane * 8); g[2 * k + 1] = *(const f32x4*)(P.final_g + k * 512 + lane * 8 + 4); }
    for (int row = bx * 8 + wid; row < MTOK; row += G * 8) {
        const f32x4* sp = (const f32x4*)(ssq + (size_t)row * 16);
        const f32x4 st = (sp[0] + sp[1]) + (sp[2] + sp[3]);
        const float rstd = __builtin_amdgcn_rsqf(((st[0] + st[1]) + (st[2] + st[3])) * (1.0f / 1024.0f) + 1e-6f);
        float* op = P.out + (size_t)row * 1024;
#pragma unroll
        for (int k = 0; k < 2; ++k) { const int c = k * 512 + lane * 8; const u32x4 hv = *(const u32x4*)(h16 + ((size_t)(2 * k + (lane >> 5)) * MTOK + row) * 256 + (lane & 31) * 8);
            const f32x4 v0 = {bflo(hv.x), bfhi(hv.x), bflo(hv.y), bfhi(hv.y)}, v1 = {bflo(hv.z), bfhi(hv.z), bflo(hv.w), bfhi(hv.w)};
            __builtin_nontemporal_store(v0 * rstd * g[2 * k], (f32x4*)(op + c)); __builtin_nontemporal_store(v1 * rstd * g[2 * k + 1], (f32x4*)(op + c + 4)); }
    }
}

#define XB_TMO      128
#define XB_XCNT(j)  (256  + 64 * (j))
#define XB_XSUB(j)  (1280 + 64 * (j))
#define XB_XGEN(j)  (2304 + 64 * (j))
#define XB_TOP      3328
#define XB_TOPGEN   3392
#define XCD_BAR_WORDS 3456
#define XB_SPIN_CAP (1u << 18)
#define LAS __attribute__((address_space(3)))

__device__ __forceinline__ unsigned xb_ld(unsigned* p)              { return __hip_atomic_load(p, __ATOMIC_RELAXED, __HIP_MEMORY_SCOPE_AGENT); }
__device__ __forceinline__ unsigned xb_add(unsigned* p, unsigned v) { return __hip_atomic_fetch_add(p, v, __ATOMIC_RELAXED, __HIP_MEMORY_SCOPE_AGENT); }
__device__ __forceinline__ unsigned xb_xcc_id() { return (unsigned)__builtin_amdgcn_s_getreg((3 << 11) | 20) & 0xFu; }
#define XB_SPIN(cond, bar) do { unsigned _sp = 0; while (cond) { __builtin_amdgcn_s_sleep(1); \
    if ((++_sp & 255u) == 0u) { if (xb_ld(&(bar)[XB_TMO])) break; if (_sp > XB_SPIN_CAP) { atomicAdd(&(bar)[XB_TMO], 1u); break; } } } } while (0)

struct XcdBarrier {
    unsigned* bar; unsigned x;
    volatile LAS unsigned* st;
};

__device__ __forceinline__ XcdBarrier xcd_barrier_post(unsigned* bar, volatile LAS unsigned* st) {
    XcdBarrier b; b.bar = bar; b.x = xb_xcc_id(); b.st = st;
    if (threadIdx.x == 0) (void)xb_add(&bar[XB_XCNT(b.x)], 1u);
    return b;
}
__device__ __forceinline__ void xcd_barrier_complete(unsigned* bar, unsigned x, unsigned& nloc, unsigned& nx) {
    const unsigned G = gridDim.x * gridDim.y * gridDim.z;
    unsigned sum, cnt, mine, sp = 0u;
    for (;;) {
        sum = 0u; cnt = 0u; mine = 0u;
#pragma unroll
        for (unsigned j = 0; j < 16; ++j) { const unsigned c = xb_ld(&bar[XB_XCNT(j)]); sum += c; cnt += (c > 0u) ? 1u : 0u; mine = (j == x) ? c : mine; }
        if (sum == G) break;
        __builtin_amdgcn_s_sleep(1);
        if ((++sp & 255u) == 0u) { if (xb_ld(&bar[XB_TMO])) break; if (sp > XB_SPIN_CAP) { atomicAdd(&bar[XB_TMO], 1u); break; } }
    }
    nloc = mine > 0u ? mine : 1u; nx = cnt > 0u ? cnt : 1u;
}

__device__ __forceinline__ void xcd_barrier(const XcdBarrier& b) {
    asm volatile("s_waitcnt vmcnt(0)" ::: "memory");
    __syncthreads();
    if (threadIdx.x == 0) {
        unsigned* bar = b.bar;
        __builtin_amdgcn_s_waitcnt(0);
        unsigned nloc = b.st[0], nx = b.st[1];
        if (nloc == 0u) { xcd_barrier_complete(bar, b.x, nloc, nx); b.st[0] = nloc; b.st[1] = nx; }
        const unsigned old = xb_add(&bar[XB_XSUB(b.x)], 1u);
        const unsigned gen = old / nloc;
        if (old + 1u == (gen + 1u) * nloc) {
            __builtin_amdgcn_fence(__ATOMIC_RELEASE, "agent");
            asm volatile("s_waitcnt vmcnt(0)" ::: "memory");
            const unsigned og = xb_add(&bar[XB_TOP], 1u);
            const unsigned tg = og / nx;
            if (og + 1u == (tg + 1u) * nx) xb_add(&bar[XB_TOPGEN], 1u);
            else XB_SPIN(xb_ld(&bar[XB_TOPGEN]) == tg, bar);
            __builtin_amdgcn_fence(__ATOMIC_ACQUIRE, "agent");
            xb_add(&bar[XB_XGEN(b.x)], 1u);
            asm volatile("s_waitcnt vmcnt(0)" ::: "memory");
        } else {
            XB_SPIN(xb_ld(&bar[XB_XGEN(b.x)]) == gen, bar);
            __builtin_amdgcn_fence(__ATOMIC_ACQUIRE, "agent");
            asm volatile("s_waitcnt vmcnt(0)" ::: "memory");
        }
    }
    __syncthreads();
}


template <class Sched> __device__ __forceinline__ void stage_units(PG8_LAS unsigned char* l3, const Sched& S, const float* ssq, const float* sw, int N) {
    const int tid = opaque_tid();
    pg8::Unit u;
    for (int i = 0; i < STG_SLOTS && S.next(i, u); ++i) {
        PG8_LAS float* slot = (PG8_LAS float*)(l3 + STG_OFF + i * 2048);
        if (tid < 256) { const f32x4* sp = (const f32x4*)(ssq + (size_t)(u.pm * 256 + tid) * 16); const f32x4 st = (sp[0] + sp[1]) + (sp[2] + sp[3]);
            slot[tid] = __builtin_amdgcn_rsqf(((st[0] + st[1]) + (st[2] + st[3])) * (1.0f / 1024.0f) + 1e-6f); }
        else slot[tid] = sw[(size_t)(u.pm >> 5) * N + u.pn * 256 + (tid - 256)];
    }
    __syncthreads();
}
__device__ __forceinline__ void stagger(int bx, int ticks) {
    if (ticks > 0 && ((bx >> 3) & 1)) { const unsigned long long t0 = __builtin_amdgcn_s_memrealtime(); while (__builtin_amdgcn_s_memrealtime() - t0 < (unsigned long long)ticks) __builtin_amdgcn_s_sleep(32); }
}
__global__ void __launch_bounds__(512) yoco_fwd(Params Pin) {
    extern __shared__ __attribute__((aligned(16))) unsigned char smem[];
    cg::grid_group grid = cg::this_grid();
    PG8_LAS unsigned char* lds3 = (PG8_LAS unsigned char*)smem;
    if (threadIdx.x < 4) ((volatile LAS unsigned*)(lds3 + 131072))[threadIdx.x] = 0u;
    __syncthreads();
    { const Params P0_ = kparams(); (void)xcd_barrier_post((unsigned*)(P0_.ws + WS_BAR), (volatile LAS unsigned*)(lds3 + 131072)); }
#define GRID_BAR() do { const Params Pb_ = kparams(); XcdBarrier xb_; xb_.bar = (unsigned*)(Pb_.ws + WS_BAR); xb_.x = xb_xcc_id(); xb_.st = (volatile LAS unsigned*)(lds3 + 131072); xcd_barrier(xb_); } while (0)

    for (int rpro = 0; rpro < REP_PRO; ++rpro) {
    { PHASE_BEGIN
      p0_mod(P, (char*)smem, bx);
      for (int rep = 0; rep < REP_P0W; ++rep) p0_weights(P, (char*)smem, bx, G); }
    for (int rep = 0; rep < REP_SYNC; ++rep) GRID_BAR();
    GRID_BAR();
    { const Params Pq_ = kparams(); if (Pq_.ws == nullptr) grid.sync(); }
    { PHASE_BEGIN
      { pg8::Gemm g{(const bf16_t*)(ws + WS_WGT), (const bf16_t*)(ws + WS_BFOLD), 4096, 8192, 512, 0, 0};
        pg8::FoldOrder S{G, bx}; pg8::EpiFold E{(bf16_t*)(ws + WT_IN), (bf16_t*)(ws + WT_IN + 8 * MiB)};
        pg8::gemm_phase<pg8::EpiFold, pg8::FoldOrder>(lds3, g, S, E, nullptr); }
      if (bx == G - 1) p1_gs(P);
      p1_prep(P, bx, G); }
    GRID_BAR();
    { PHASE_BEGIN
      p2_sw(P, (char*)smem, bx, G);
      p2_scale(P, bx, G); }
    GRID_BAR();

    }
    for (int l = 0; l < 2; ++l) {
        for (int rep = 0; rep < (l == 0 ? REP_G1 : 1); ++rep) { PHASE_BEGIN
          stagger(bx, STAG_TICKS);
          pg8::Gemm g{H16, l == 0 ? (const bf16_t*)(ws + WS_WTB0) : (const bf16_t*)P.out, MTOK, 4096, 1024, 8 * MiB, 1};
          pg8::StaticOrder S; S.init(MTOK, 4096, G, bx);
          stage_units(lds3, S, ssq, sw + l * 4 * 4096, 4096);
          pg8::EpiIn E{R0, R1, lds3 + STG_OFF, 1.0f, 0, 0, 0};
          pg8::gemm_phase<pg8::EpiIn, pg8::StaticOrder>(lds3, g, S, E, nullptr); }
        GRID_BAR();
        for (int rep = 0; rep < REP_PG; ++rep) { PHASE_BEGIN
          pool_gate((char*)smem, R0, R1, rep == REP_PG - 1 ? R1 : R2, P.a_scale + l * 2048, bx, G); }
        GRID_BAR();
        for (int rep = 0; rep < (l == 0 ? REP_G2 : 1); ++rep) { PHASE_BEGIN
          pg8::Gemm g{R1, (const bf16_t*)(ws + WT_OUT + l * 4 * MiB), MTOK, 1024, 2048, 0, 1};
          pg8::StaticOrder S; S.init(MTOK, 1024, G, bx);
          pg8::EpiOut E{l == 0 ? P.x : nullptr, H16, mod + l * 4 * 3072 + 2048, 3072, ssq};
          pg8::gemm_phase<pg8::EpiOut, pg8::StaticOrder>(lds3, g, S, E, nullptr); }
        GRID_BAR();
    }
    for (int l = 0; l < 2; ++l) {
        if (l == 0) for (int rep = 0; rep < REP_KV; ++rep) { PHASE_BEGIN
          stagger(bx, STAG_TICKS);
          pg8::Gemm g{H16, (const bf16_t*)((const unsigned char*)P.out + 3 * 32 * MiB), MTOK, 4096, 1024, 8 * MiB, 1};
          pg8::StaticOrder S; S.init(MTOK, 4096, G, bx);
          stage_units(lds3, S, ssq, sw + 4 * 4 * 4096, 4096);
          pg8::EpiIn E{R1, R2, lds3 + STG_OFF, 1.0f, 0, 0, 1};
          pg8::gemm_phase<pg8::EpiIn, pg8::StaticOrder>(lds3, g, S, E, nullptr); }
        if (l == 0 && KVQ_BAR) GRID_BAR();
        for (int rep = 0; rep < (l == 0 ? REP_Q : 1); ++rep) { PHASE_BEGIN
          pg8::Gemm g{H16, (const bf16_t*)((const unsigned char*)P.out + (size_t)(1 + l) * 32 * MiB), MTOK, 2048, 1024, 8 * MiB, 1};
          pg8::StaticOrder S; S.init(MTOK, 2048, G, bx);
          stage_units(lds3, S, ssq, sw + (2 + l) * 4 * 4096, 4096);
          pg8::EpiIn E{R0, R0, lds3 + STG_OFF, QSCALE, 0, 0, 0};
          pg8::gemm_phase<pg8::EpiIn, pg8::StaticOrder>(lds3, g, S, E, nullptr); }
        GRID_BAR();
        for (int rep = 0; rep < REP_AT; ++rep) { PHASE_BEGIN
          att::attn_phase((char*)smem, lds3, R0, R1, R2, P.b_rel_bias + l * 16 * 257, vcu, G, rep == REP_AT - 1 || P.ws == nullptr); }
        GRID_BAR();
        { PHASE_BEGIN
          stagger(bx, STAG_TICKS);
          pg8::Gemm g{H16, (const bf16_t*)((const unsigned char*)P.out + (size_t)(1 + l) * 32 * MiB) + (size_t)2048 * 1024, MTOK, 2048, 1024, 8 * MiB, 1};
          pg8::StaticOrder S; S.init(MTOK, 2048, G, bx);
          stage_units(lds3, S, ssq, sw + (2 + l) * 4 * 4096 + 2048, 4096);
          pg8::EpiIn E{R0, R0, lds3 + STG_OFF, 1.0f, 1, 1, 0};
          pg8::gemm_phase<pg8::EpiIn, pg8::StaticOrder>(lds3, g, S, E, nullptr); }
        GRID_BAR();
        { PHASE_BEGIN
          pg8::Gemm g{R0, (const bf16_t*)(ws + WT_BOUT + l * 4 * MiB), MTOK, 1024, 2048, 0, 1};
          pg8::StaticOrder S; S.init(MTOK, 1024, G, bx);
          pg8::EpiOut E{nullptr, H16, mod + (2 + l) * 4 * 3072 + 2048, 3072, ssq};
          pg8::gemm_phase<pg8::EpiOut, pg8::StaticOrder>(lds3, g, S, E, nullptr); }
        GRID_BAR();
    }
    { PHASE_BEGIN
      final_norm(P, bx, G); }
}

extern "C" void kernel_launch(void* const* d_in, const int* in_sizes, int n_in, void* d_out, int out_size, void* d_ws, size_t ws_size, hipStream_t stream) {
    static int grid_blocks = 0;
    if (grid_blocks == 0) {
        if (n_in != 17 || in_sizes[0] != MTOK * DM || out_size != MTOK * DM || ws_size < WS_END) {
            fprintf(stderr, "kernel_launch: shape/workspace mismatch: n_in %d in0 %d out %d ws %zu (need %zu)\n", n_in, n_in > 0 ? in_sizes[0] : -1, out_size, ws_size, (size_t)WS_END); grid_blocks = -1; return; }
        int dev = 0, cus = 0, per_cu = 0;
        hipGetDevice(&dev); hipDeviceGetAttribute(&cus, hipDeviceAttributeMultiprocessorCount, dev);
        if (hipFuncSetAttribute((const void*)yoco_fwd, hipFuncAttributeMaxDynamicSharedMemorySize, LDS_BYTES) != hipSuccess) { fprintf(stderr, "kernel_launch: hipFuncSetAttribute failed\n"); grid_blocks = -1; return; }
        if (hipOccupancyMaxActiveBlocksPerMultiprocessor(&per_cu, (const void*)yoco_fwd, 512, LDS_BYTES) != hipSuccess || per_cu < 1) { fprintf(stderr, "kernel_launch: occupancy query gave %d\n", per_cu); per_cu = 1; (void)hipGetLastError(); }
        grid_blocks = cus * 1;
    }
    if (grid_blocks < 0) return;
    (void)hipMemsetAsync((char*)d_ws + WS_MOD, 0, ZERO_BYTES, stream);
    Params p{};
    p.x = (const float*)d_in[0]; p.c = (const float*)d_in[1]; p.ada_w = (const float*)d_in[2]; p.ada_b = (const float*)d_in[3]; p.norm_g = (const float*)d_in[4];
    p.a_w_in = (const float*)d_in[5]; p.a_w_group = (const float*)d_in[6]; p.a_scale = (const float*)d_in[7]; p.a_w_out = (const float*)d_in[8];
    p.kv_norm_g = (const float*)d_in[9]; p.kv_ada_w = (const float*)d_in[10]; p.kv_ada_b = (const float*)d_in[11]; p.w_kv = (const float*)d_in[12];
    p.b_w_in = (const float*)d_in[13]; p.b_rel_bias = (const float*)d_in[14]; p.b_w_out = (const float*)d_in[15]; p.final_g = (const float*)d_in[16];
    p.out = (float*)d_out; p.ws = (unsigned char*)d_ws;
    void* args[] = {&p};
    const hipError_t e = hipLaunchCooperativeKernel((const void*)yoco_fwd, dim3(grid_blocks), dim3(512), args, LDS_BYTES, stream);
    if (e != hipSuccess) fprintf(stderr, "kernel_launch: cooperative launch failed: %s (grid %d)\n", hipGetErrorString(e), grid_blocks);
}
```
